# Optimizing an MI355X kernel written in HIP

```python
import jax, jax.numpy as jnp
from jax import lax
import numpy as np

D_MODEL = 2048
BATCH = 8
SEQ = 4096
DEPTH = 1

D_MIX = D_MODEL
HEAD_DIM = 128
RET_HEADS = (D_MIX // 2) // HEAD_DIM
SB_HEADS = (D_MIX // 2) // HEAD_DIM
RET_WIDTH = RET_HEADS * HEAD_DIM
SB_WIDTH = SB_HEADS * HEAD_DIM
IN_COLS = 4 * RET_WIDTH + 4 * SB_WIDTH
CHUNK = 128
Q_BLOCK = 128
ROPE_THETA = 10000.0
EPS = 1e-6

kernel_name = "hybrid_retention_stickbreaking_block"


def rmsnorm(x, g):
    xf = x.astype(jnp.float32)
    y = xf * lax.rsqrt(jnp.mean(xf * xf, axis=-1, keepdims=True) + EPS)
    return (y * g.astype(jnp.float32)).astype(x.dtype)


def rotary(x):
    S, d = x.shape[1], x.shape[-1]
    half = d // 2
    inv = ROPE_THETA ** (-jnp.arange(half, dtype=jnp.float32) / half)
    ang = jnp.arange(S, dtype=jnp.float32)[:, None] * inv[None, :]
    cos = jnp.cos(ang)[None, :, None, :]
    sin = jnp.sin(ang)[None, :, None, :]
    xf = x.astype(jnp.float32)
    x1, x2 = xf[..., :half], xf[..., half:]
    out = jnp.concatenate([x1 * cos - x2 * sin, x1 * sin + x2 * cos], axis=-1)
    return out.astype(x.dtype)


def retention(q, k, v):
    B, S, H, d = q.shape
    nc = S // CHUNK
    dt = q.dtype
    lg = jnp.log1p(-jnp.exp2(-5.0 - jnp.arange(H, dtype=jnp.float32)))

    def to_chunks(t):
        return t.reshape(B, nc, CHUNK, H, t.shape[-1]).transpose(0, 3, 1, 2, 4)

    qc, kc, vc = to_chunks(q), to_chunks(k) * (d ** -0.5), to_chunks(v)
    n = jnp.arange(CHUNK, dtype=jnp.float32)
    rel = n[:, None] - n[None, :]
    decay = jnp.where(rel >= 0, jnp.exp(lg[:, None, None] * jnp.maximum(rel, 0.0)), 0.0)
    xi = jnp.exp(lg[:, None] * (n + 1.0))
    zeta = jnp.exp(lg[:, None] * (CHUNK - 1.0 - n))
    gamma_c = jnp.exp(lg * CHUNK).astype(dt)

    scores = jnp.einsum('bhcnd,bhcmd->bhcnm', qc, kc) * decay[None, :, None].astype(dt)
    intra = jnp.einsum('bhcnm,bhcme->bhcne', scores, vc)

    kv = jnp.einsum('bhcmd,bhcme->cbhde', kc * zeta[None, :, None, :, None].astype(dt), vc)

    def step(R, kv_c):
        return gamma_c[None, :, None, None] * R + kv_c, R

    _, R_prev = lax.scan(step, jnp.zeros_like(kv[0]), kv)
    cross = jnp.einsum('bhcnd,cbhde->bhcne', qc * xi[None, :, None, :, None].astype(dt), R_prev)
    out = intra + cross
    return out.transpose(0, 2, 3, 1, 4).reshape(B, S, H, -1)


def stick_breaking(q, k, v):
    S, d = q.shape[1], q.shape[-1]
    scale = d ** -0.5
    qh, kh, vh = (t.transpose(0, 2, 1, 3) for t in (q, k, v))
    outs = []
    for start in range(0, S, Q_BLOCK):
        end = start + Q_BLOCK
        qb, kb, vb = qh[:, :, start:end], kh[:, :, :end], vh[:, :, :end]
        z = jnp.einsum('bhtd,bhsd->bhts', qb, kb).astype(jnp.float32) * scale
        t_idx = start + jnp.arange(Q_BLOCK)[:, None]
        s_idx = jnp.arange(end)[None, :]
        causal = s_idx < t_idx
        log_keep = jnp.where(causal, jax.nn.log_sigmoid(-z), 0.0)
        log_a = jax.nn.log_sigmoid(z) + lax.cumsum(log_keep, axis=3, reverse=True) - log_keep
        a = jnp.where(causal, jnp.exp(log_a), 0.0).astype(vb.dtype)
        outs.append(jnp.einsum('bhts,bhse->bhte', a, vb))
    return jnp.concatenate(outs, axis=2).transpose(0, 2, 1, 3)


def head_groupnorm(y, g, b):
    B, S, H, e = y.shape
    yf = y.astype(jnp.float32)
    mu = jnp.mean(yf, axis=-1, keepdims=True)
    var = jnp.mean(jnp.square(yf - mu), axis=-1, keepdims=True)
    yn = ((yf - mu) * lax.rsqrt(var + EPS)).reshape(B, S, H * e)
    return (yn * g.astype(jnp.float32) + b.astype(jnp.float32)).astype(y.dtype)


def head_rmsnorm(y, g):
    B, S, H, e = y.shape
    yf = y.astype(jnp.float32)
    yn = (yf * lax.rsqrt(jnp.mean(yf * yf, axis=-1, keepdims=True) + EPS)).reshape(B, S, H * e)
    return (yn * g.astype(jnp.float32)).astype(y.dtype)


def setup_inputs(seed: int = 0) -> dict:
    key = jax.random.key(seed)
    ks = jax.random.split(key, 9)
    f32 = jnp.float32
    x = jax.random.normal(ks[0], (BATCH, SEQ, D_MODEL), f32)
    norm_gain = 1.0 + 0.02 * jax.random.normal(ks[1], (DEPTH, D_MODEL), f32)
    w_in = jax.random.normal(ks[2], (DEPTH, D_MODEL, IN_COLS), f32) * D_MODEL ** -0.5
    ret_gn_gain = 1.0 + 0.02 * jax.random.normal(ks[3], (DEPTH, RET_WIDTH), f32)
    ret_gn_bias = 0.02 * jax.random.normal(ks[4], (DEPTH, RET_WIDTH), f32)
    sb_norm_gain = 1.0 + 0.02 * jax.random.normal(ks[5], (DEPTH, SB_WIDTH), f32)
    w_out = jax.random.normal(ks[6], (DEPTH, D_MIX, D_MODEL), f32) * D_MIX ** -0.5
    final_norm_gain = 1.0 + 0.02 * jax.random.normal(ks[7], (D_MODEL,), f32)
    return {"x": x, "norm_gain": norm_gain, "w_in": w_in, "ret_gn_gain": ret_gn_gain,
            "ret_gn_bias": ret_gn_bias, "sb_norm_gain": sb_norm_gain, "w_out": w_out,
            "final_norm_gain": final_norm_gain}


def reference(x, norm_gain, w_in, ret_gn_gain, ret_gn_bias, sb_norm_gain, w_out, final_norm_gain):
    B, S, _ = x.shape
    splits = [RET_WIDTH * i for i in range(1, 5)] + [4 * RET_WIDTH + SB_WIDTH * i for i in range(1, 4)]
    for l in range(DEPTH):
        h = rmsnorm(x, norm_gain[l])
        proj = jnp.einsum('bsd,dc->bsc', h, w_in[l])
        rq, rk, rv, rg, sq, sk, sv, sg = jnp.split(proj, splits, axis=-1)
        heads = lambda t, H: t.reshape(B, S, H, HEAD_DIM)
        ret = retention(rotary(heads(rq, RET_HEADS)), rotary(heads(rk, RET_HEADS)), heads(rv, RET_HEADS))
        ret = jax.nn.silu(rg) * head_groupnorm(ret, ret_gn_gain[l], ret_gn_bias[l])
        sb = stick_breaking(heads(sq, SB_HEADS), heads(sk, SB_HEADS), heads(sv, SB_HEADS))
        sb = jax.nn.silu(sg) * head_rmsnorm(sb, sb_norm_gain[l])
        mix = jnp.concatenate([ret, sb], axis=-1)
        x = x + jnp.einsum('bsc,cd->bsd', mix, w_out[l])
    return rmsnorm(x, final_norm_gain)
```

```cpp
#include <hip/hip_runtime.h>
#include <hip/hip_cooperative_groups.h>
#include <cstdio>
namespace cg = cooperative_groups;

#define LAS __attribute__((address_space(3)))
#define DI __device__ __forceinline__
typedef unsigned short bf16_t;
typedef short bf16x8 __attribute__((ext_vector_type(8)));
typedef short s16x4 __attribute__((ext_vector_type(4)));
typedef float f32x2 __attribute__((ext_vector_type(2)));
typedef float f32x4 __attribute__((ext_vector_type(4)));
typedef float f32x16 __attribute__((ext_vector_type(16)));
typedef unsigned u32x2 __attribute__((ext_vector_type(2)));
typedef unsigned u32x4 __attribute__((ext_vector_type(4)));
typedef __bf16 bf16v2 __attribute__((ext_vector_type(2)));

constexpr int SEQ = 4096, DM = 2048, NTOK = 32768, INC = 8192, HD = 128;
constexpr float EPS = 1e-6f;
constexpr float LOG2E = 1.4426950408889634f;
constexpr float KSCALE = 0.08838834764831845f;

constexpr size_t SZ64 = 67108864ull;
constexpr size_t WS_HB = 0;
constexpr size_t WS_MIX = 0;
constexpr size_t WS_WTIN = 134217728ull;
constexpr size_t WS_WTOUT = WS_WTIN + 33554432ull;
constexpr size_t WS_RQ = WS_WTOUT + 8388608ull;
constexpr size_t WS_RK = WS_RQ + SZ64;
constexpr size_t WS_KTZ = WS_RK + SZ64;
constexpr size_t WS_RVT = WS_KTZ + SZ64;
constexpr size_t WS_RG = WS_RVT + SZ64;
constexpr size_t WS_SQ = WS_RG + SZ64;
constexpr size_t WS_SK = WS_SQ + SZ64;
constexpr size_t WS_SVT = WS_SK + SZ64;
constexpr size_t WS_SG = WS_SVT + SZ64;
constexpr size_t WS_KV = WS_SG + SZ64;
constexpr size_t WS_RP = WS_KV + 134217728ull;
constexpr size_t WS_ROPE = WS_RP + SZ64;
constexpr size_t WS_SSP = WS_ROPE + 2097152ull;
constexpr size_t WS_END = WS_SSP + 4194304ull;

struct Params {
    const float* x; const float* ng; const float* w_in; const float* gng; const float* gnb; const float* sbg; const float* w_out; const float* fg;
    float* out; unsigned char* ws; int ph_lo; int ph_hi;
};

DI unsigned pk2(float lo, float hi) { f32x2 v = {lo, hi}; bf16v2 r = __builtin_convertvector(v, bf16v2); return __builtin_bit_cast(unsigned, r); }
DI bf16_t bf1(float x) { return (bf16_t)(pk2(x, x) & 0xffffu); }
DI float ex2(float x) { return __builtin_amdgcn_exp2f(x); }
DI float lg2(float x) { return __builtin_amdgcn_logf(x); }
DI float l2gamma(int h) {
    const float x = __uint_as_float((unsigned)(127 - 5 - h) << 23);
    const float s = x * (1.f + x * (0.5f + x * (0.33333334f + x * (0.25f + x * (0.2f + x * 0.16666667f)))));
    return -s * LOG2E;
}
DI float silu(float v) { return v * __builtin_amdgcn_rcpf(1.f + ex2(-v * LOG2E)); }
DI float wave_sum(float v) {
#pragma unroll
    for (int o = 32; o >= 1; o >>= 1) v += __shfl_xor(v, o);
    return v;
}
#define MFMA16(a, b, c) __builtin_amdgcn_mfma_f32_16x16x32_bf16((a), (b), (c), 0, 0, 0)
#define MFMA32(a, b, c) __builtin_amdgcn_mfma_f32_32x32x16_bf16((a), (b), (c), 0, 0, 0)

DI int dst_row_in(int nsrc) {
    const int pn = nsrc >> 8, off = nsrc & 255, grp = pn >> 2, bj = off >> 7, cc = off & 127;
    int rho;
    if (grp < 2) { const int n = cc >> 6, a = cc & 63; rho = 32 * (a >> 4) + 16 * n + (a & 15); }
    else { const int wc = cc >> 5, fq = (cc >> 3) & 3, n = (cc >> 2) & 1, j = cc & 3; rho = 32 * wc + 16 * n + 4 * fq + j; }
    return pn * 256 + bj * 128 + rho;
}
DI int dst_row_out(int nsrc) {
    const int pn = nsrc >> 8, off = nsrc & 255, bj = off >> 7, cc = off & 127;
    const int wc = cc >> 5, fq = (cc >> 3) & 3, n = (cc >> 2) & 1, j = cc & 3;
    return pn * 256 + bj * 128 + 32 * wc + 16 * n + 4 * fq + j;
}

DI void phase_prep(const Params& p, LAS unsigned char* lds) {
    const int tid = threadIdx.x, wid = tid >> 6, lane = tid & 63;
    unsigned char* ws = p.ws;
    {
        float* cosT = (float*)(ws + WS_ROPE); float* sinT = cosT + 4096 * 64;
        for (int idx = blockIdx.x * 512 + tid; idx < 4096 * 64; idx += gridDim.x * 512) {
            const int s = idx >> 6, a = idx & 63;
            const float inv = (float)exp(-(double)a * (9.210340371976184 / 64.0));
            const float ang = (float)s * inv;
            const double x = (double)ang;
            const double kq = rint(x * 0.6366197723675814);
            const double r = (x - kq * 1.5707963267948966) - kq * 6.123233995736766e-17;
            const double r2 = r * r;
            const double sn = r * (1.0 + r2 * (-1.0 / 6 + r2 * (1.0 / 120 + r2 * (-1.0 / 5040 + r2 * (1.0 / 362880 + r2 * (-1.0 / 39916800 + r2 * (1.0 / 6227020800.0)))))));
            const double cs = 1.0 + r2 * (-0.5 + r2 * (1.0 / 24 + r2 * (-1.0 / 720 + r2 * (1.0 / 40320 + r2 * (-1.0 / 3628800 + r2 * (1.0 / 479001600.0 + r2 * (-1.0 / 87178291200.0)))))));
            const int q = ((int)kq) & 3;
            const double c_ = (q == 0) ? cs : (q == 1) ? -sn : (q == 2) ? -cs : sn;
            const double s_ = (q == 0) ? sn : (q == 1) ? cs : (q == 2) ? -sn : -cs;
            cosT[idx] = (float)c_; sinT[idx] = (float)s_;
        }
    }
    {
        bf16_t* hb = (bf16_t*)(ws + WS_HB);
        for (int row = blockIdx.x * 8 + wid; row < NTOK; row += gridDim.x * 8) {
            const f32x4* xr = (const f32x4*)(p.x + (size_t)row * DM);
            f32x4 v[8]; float ss = 0.f;
#pragma unroll
            for (int i = 0; i < 8; ++i) { v[i] = xr[lane + 64 * i]; ss += v[i][0] * v[i][0] + v[i][1] * v[i][1] + v[i][2] * v[i][2] + v[i][3] * v[i][3]; }
            ss = wave_sum(ss);
            const float rstd = rsqrtf(ss * (1.f / DM) + EPS);
#pragma unroll
            for (int i = 0; i < 8; ++i) {
                u32x2 w; w.x = pk2(v[i][0] * rstd, v[i][1] * rstd); w.y = pk2(v[i][2] * rstd, v[i][3] * rstd);
                *(u32x2*)(hb + (size_t)row * DM + (lane + 64 * i) * 4) = w;
            }
        }
    }
    {
        LAS float* tile = (LAS float*)lds;
        bf16_t* wtin = (bf16_t*)(ws + WS_WTIN); bf16_t* wtout = (bf16_t*)(ws + WS_WTOUT);
        for (int t = blockIdx.x; t < 4096 + 1024; t += gridDim.x) {
            const bool isin = t < 4096;
            const int tt = isin ? t : t - 4096;
            const int ncols = isin ? INC : DM;
            const int ntn = ncols / 64;
            const int kt = tt / ntn, nt = tt % ntn, k0 = kt * 64, n0 = nt * 64;
            const float* src = isin ? p.w_in : p.w_out;
#pragma unroll
            for (int ps = 0; ps < 2; ++ps) {
                const int i = (tid >> 4) + 32 * ps, c4 = (tid & 15) * 4;
                f32x4 v = *(const f32x4*)(src + (size_t)(k0 + i) * ncols + n0 + c4);
                const float g = isin ? p.ng[k0 + i] : 1.f;
                tile[i * 65 + c4 + 0] = v[0] * g; tile[i * 65 + c4 + 1] = v[1] * g; tile[i * 65 + c4 + 2] = v[2] * g; tile[i * 65 + c4 + 3] = v[3] * g;
            }
            __syncthreads();
            {
                const int nl = tid >> 3, ks = tid & 7;
                float f[8];
#pragma unroll
                for (int j = 0; j < 8; ++j) f[j] = tile[(ks * 8 + j) * 65 + nl];
                u32x4 w; w.x = pk2(f[0], f[1]); w.y = pk2(f[2], f[3]); w.z = pk2(f[4], f[5]); w.w = pk2(f[6], f[7]);
                const int dr = isin ? dst_row_in(n0 + nl) : dst_row_out(n0 + nl);
                bf16_t* dst = (isin ? wtin : wtout) + (size_t)dr * DM + k0 + ks * 8;
                *(u32x4*)dst = w;
            }
            __syncthreads();
        }
    }
}

constexpr int BM = 256, BK = 64, HALF = 128, HTB = HALF * BK * 2, NXCD = 8, WGM = 8;
__host__ __device__ __forceinline__ int lds_byte(int r, int c) { const int st = (r >> 4) * 2 + (c >> 5), rr = r & 15, cc = c & 31, ob = rr * 64 + cc * 2; return st * 1024 + (ob ^ (((ob >> 9) & 1) << 5)); }
__host__ __device__ __forceinline__ void stage_rc(int b, int& R, int& C) { const int st = b / 1024, sb = b % 1024, swz = sb ^ (((sb >> 9) & 1) << 5); R = (st >> 1) * 16 + swz / 64; C = (st & 1) * 32 + (swz % 64) / 2; }
struct Unit { int pm, pn; };
DI bool next_unit(int i, int nM, int nN, Unit& u) {
    const int nwg = nM * nN; const long L = (long)i * gridDim.x + blockIdx.x; if (L >= nwg) return false;
    int wgid = (int)L; { const int q = nwg / NXCD, r = nwg % NXCD, xcd = wgid % NXCD, off = wgid / NXCD; wgid = (xcd < r ? xcd * (q + 1) : r * (q + 1) + (xcd - r) * q) + off; }
    const int nig = WGM * nN, gid = wgid / nig, fm = gid * WGM, gsz = (nM - fm) < WGM ? (nM - fm) : WGM;
    u.pm = fm + ((wgid % nig) % gsz); u.pn = (wgid % nig) / gsz; return true;
}

template <class Epi>
DI void gemm_phase(LAS unsigned char* lds, const bf16_t* gA, const bf16_t* gBt, int M, int N, int K, const Epi& E) {
    const int tid = threadIdx.x, wid = __builtin_amdgcn_readfirstlane(tid >> 6), lane = tid & 63, wr = wid >> 2, wc = wid & 3, fr = lane & 15, fq = lane >> 4;
    const int nt = K / BK, nM = M / BM, nN = N / BM;
    unsigned voffA[2];
#pragma unroll
    for (int i = 0; i < 2; ++i) { int R, C; stage_rc(tid * 16 + i * 8192, R, C); voffA[i] = (unsigned)(R * K + C) * 2u; }
    const size_t kstep = (size_t)(BK * 2);
    const size_t hstep = (size_t)HALF * K * 2;
    const size_t tstep = 2 * hstep;
    const unsigned ldsw = (unsigned)wid * 1024u;
    const int aoff = lds_byte(wr * 64 + fr, fq * 8), boff = lds_byte(wc * 32 + fr, fq * 8);
#define PG8_SA(b, h) (((b) * 2 + (h)) * HTB)
#define PG8_SB(b, h) ((4 + (b) * 2 + (h)) * HTB)
#define PG8_STAGE(bufoff, gbase) do { _Pragma("unroll") for (int _i = 0; _i < 2; ++_i) \
        __builtin_amdgcn_global_load_lds((const unsigned*)((const char*)(gbase) + voffA[_i]), (LAS unsigned*)(lds + (bufoff) + ldsw + _i * 8192), 16, 0, 0); } while (0)
#define PG8_LDA(dst, b, h) do { _Pragma("unroll") for (int m = 0; m < 4; ++m) _Pragma("unroll") for (int k = 0; k < 2; ++k) dst[m][k] = *(const LAS bf16x8*)(lds + PG8_SA(b, h) + aoff + m * 2048 + k * 1024); } while (0)
#define PG8_LDB(dst, b, h) do { _Pragma("unroll") for (int n = 0; n < 2; ++n) _Pragma("unroll") for (int k = 0; k < 2; ++k) dst[n][k] = *(const LAS bf16x8*)(lds + PG8_SB(b, h) + boff + n * 2048 + k * 1024); } while (0)
#define PG8_MMA(ai, bj, At, Bt) do { __builtin_amdgcn_s_setprio(1); _Pragma("unroll") for (int m = 0; m < 4; ++m) _Pragma("unroll") for (int n = 0; n < 2; ++n) _Pragma("unroll") for (int k = 0; k < 2; ++k) \
        acc[ai][bj][m][n] = __builtin_amdgcn_mfma_f32_16x16x32_bf16(Bt[n][k], At[m][k], acc[ai][bj][m][n], 0, 0, 0); __builtin_amdgcn_s_setprio(0); } while (0)
#define PG8_WAIT_V(n) asm volatile("s_waitcnt vmcnt(" #n ")" ::: "memory")
#define PG8_WAIT_L(n) asm volatile("s_waitcnt lgkmcnt(" #n ")" ::: "memory")
#define PG8_BAR __builtin_amdgcn_s_barrier()
#define PG8_SCHED __builtin_amdgcn_sched_barrier(0)
    Unit cur, nxt; int ui = 0;
    if (!next_unit(0, nM, nN, cur)) return;
    f32x4 acc[2][2][4][2];
#pragma unroll
    for (int a = 0; a < 2; ++a)
#pragma unroll
        for (int b = 0; b < 2; ++b)
#pragma unroll
            for (int m = 0; m < 4; ++m)
#pragma unroll
                for (int n = 0; n < 2; ++n) acc[a][b][m][n] = (f32x4){0.f, 0.f, 0.f, 0.f};
    bf16x8 At[4][2], B0[2][2], B1[2][2];
    const char* cA = (const char*)gA + (size_t)cur.pm * tstep; const char* cB = (const char*)gBt + (size_t)cur.pn * tstep;
    PG8_STAGE(PG8_SB(0, 0), cB); PG8_STAGE(PG8_SA(0, 0), cA); PG8_STAGE(PG8_SB(0, 1), cB + hstep); PG8_STAGE(PG8_SA(0, 1), cA + hstep);
    if (wr == 1) PG8_BAR;
    PG8_WAIT_V(4); PG8_BAR;
    PG8_STAGE(PG8_SB(1, 0), cB + kstep); PG8_STAGE(PG8_SA(1, 0), cA + kstep); PG8_STAGE(PG8_SB(1, 1), cB + hstep + kstep);
    PG8_WAIT_V(6); PG8_BAR;
    for (;;) {
        const bool has_next = next_unit(ui + 1, nM, nN, nxt);
        const char* nA = has_next ? (const char*)gA + (size_t)nxt.pm * tstep : cA; const char* nB = has_next ? (const char*)gBt + (size_t)nxt.pn * tstep : cB;
        for (int t = 0; t < nt; t += 2) {
            const bool last = (t == nt - 2);
            const char* a1 = cA + (size_t)(t + 1) * kstep;
            const char* a2 = last ? nA : cA + (size_t)(t + 2) * kstep; const char* b2 = last ? nB : cB + (size_t)(t + 2) * kstep;
            const char* a3 = a2 + kstep; const char* b3 = b2 + kstep;
            PG8_LDB(B0, 0, 0); PG8_SCHED; PG8_LDA(At, 0, 0); PG8_STAGE(PG8_SA(1, 1), a1 + hstep);
            PG8_WAIT_L(8); PG8_BAR; PG8_WAIT_L(0); PG8_MMA(0, 0, At, B0); PG8_BAR; PG8_SCHED;
            PG8_LDB(B1, 0, 1); PG8_STAGE(PG8_SB(0, 0), b2);
            PG8_BAR; PG8_WAIT_L(0); PG8_MMA(0, 1, At, B1); PG8_BAR;
            PG8_LDA(At, 0, 1); PG8_STAGE(PG8_SA(0, 0), a2);
            PG8_BAR; PG8_WAIT_L(0); PG8_MMA(1, 0, At, B0); PG8_BAR; PG8_SCHED;
            PG8_STAGE(PG8_SB(0, 1), b2 + hstep);
            PG8_WAIT_V(6); PG8_BAR; PG8_MMA(1, 1, At, B1); PG8_BAR;
            PG8_LDB(B0, 1, 0); PG8_SCHED; PG8_LDA(At, 1, 0); PG8_STAGE(PG8_SA(0, 1), a2 + hstep);
            PG8_WAIT_L(8); PG8_BAR; PG8_WAIT_L(0); PG8_MMA(0, 0, At, B0); PG8_BAR; PG8_SCHED;
            PG8_LDB(B1, 1, 1); PG8_STAGE(PG8_SB(1, 0), b3);
            PG8_BAR; PG8_WAIT_L(0); PG8_MMA(0, 1, At, B1); PG8_BAR;
            PG8_LDA(At, 1, 1); PG8_STAGE(PG8_SA(1, 0), a3);
            PG8_BAR; PG8_WAIT_L(0); PG8_MMA(1, 0, At, B0); PG8_BAR; PG8_SCHED;
            PG8_STAGE(PG8_SB(1, 1), b3 + hstep);
            PG8_WAIT_V(6); PG8_BAR; PG8_MMA(1, 1, At, B1); PG8_BAR;
        }
        E(acc, cur, wr, wc, fr, fq);
        if (!has_next) break;
#pragma unroll
        for (int a = 0; a < 2; ++a)
#pragma unroll
            for (int b = 0; b < 2; ++b)
#pragma unroll
                for (int m = 0; m < 4; ++m)
#pragma unroll
                    for (int n = 0; n < 2; ++n) acc[a][b][m][n] = (f32x4){0.f, 0.f, 0.f, 0.f};
        cur = nxt; cA = nA; cB = nB; ++ui;
    }
    PG8_WAIT_V(0);
    if (wr == 0) PG8_BAR;
    PG8_BAR;
#undef PG8_SA
#undef PG8_SB
#undef PG8_STAGE
#undef PG8_LDA
#undef PG8_LDB
#undef PG8_MMA
#undef PG8_WAIT_V
#undef PG8_WAIT_L
#undef PG8_BAR
#undef PG8_SCHED
}

struct Epi1 {
    unsigned char* ws;
    DI void operator()(const f32x4 (&acc)[2][2][4][2], const Unit& u, int wr, int wc, int fr, int fq) const {
        const int grp = u.pn >> 2, hb = (u.pn & 3) * 2;
        const int rowt = u.pm * BM + wr * 64 + fr;
        const int b = rowt >> 12;
        if (grp < 2) {
            bf16_t* dst = (bf16_t*)(ws + (grp == 0 ? WS_RQ : WS_RK));
            bf16_t* ktz = (bf16_t*)(ws + WS_KTZ);
            const float* cosT = (const float*)(ws + WS_ROPE); const float* sinT = cosT + 4096 * 64;
            const int a0 = 16 * wc + 4 * fq;
#pragma unroll
            for (int ai = 0; ai < 2; ++ai)
#pragma unroll
                for (int m = 0; m < 4; ++m) {
                    const int s = (rowt + ai * HALF + m * 16) & 4095;
                    const f32x4 c4 = *(const f32x4*)(cosT + s * 64 + a0), s4 = *(const f32x4*)(sinT + s * 64 + a0);
#pragma unroll
                    for (int bj = 0; bj < 2; ++bj) {
                        const int head = hb + bj;
                        const f32x4 v1 = acc[ai][bj][m][0], v2 = acc[ai][bj][m][1];
                        f32x4 o1 = v1 * c4 - v2 * s4, o2 = v1 * s4 + v2 * c4;
                        if (grp == 1) { o1 *= KSCALE; o2 *= KSCALE; }
                        bf16_t* rp = dst + ((size_t)(b * 8 + head) * SEQ + s) * HD + a0;
                        u32x2 w1, w2; w1.x = pk2(o1[0], o1[1]); w1.y = pk2(o1[2], o1[3]); w2.x = pk2(o2[0], o2[1]); w2.y = pk2(o2[2], o2[3]);
                        *(u32x2*)rp = w1; *(u32x2*)(rp + 64) = w2;
                        if (grp == 1) {
                            const float z = ex2(l2gamma(head) * (float)(127 - (s & 127)));
                            bf16_t* kt = ktz + ((size_t)(b * 8 + head) * HD + a0) * SEQ + s;
#pragma unroll
                            for (int j = 0; j < 4; ++j) { kt[(size_t)j * SEQ] = bf1(o1[j] * z); kt[(size_t)(64 + j) * SEQ] = bf1(o2[j] * z); }
                        }
                    }
                }
        } else if (grp == 2 || grp == 6) {
            bf16_t* dst = (bf16_t*)(ws + (grp == 2 ? WS_RVT : WS_SVT));
#pragma unroll
            for (int ai = 0; ai < 2; ++ai)
#pragma unroll
                for (int m = 0; m < 4; ++m) {
                    const int s = (rowt + ai * HALF + m * 16) & 4095;
#pragma unroll
                    for (int bj = 0; bj < 2; ++bj) {
                        bf16_t* vt = dst + ((size_t)(b * 8 + hb + bj) * HD + 32 * wc + 8 * fq) * SEQ + s;
#pragma unroll
                        for (int n = 0; n < 2; ++n)
#pragma unroll
                            for (int j = 0; j < 4; ++j) vt[(size_t)(4 * n + j) * SEQ] = bf1(acc[ai][bj][m][n][j] * 1.0f);
                    }
                }
        } else {
            bf16_t* dst = (bf16_t*)(ws + (grp == 3 ? WS_RG : grp == 4 ? WS_SQ : grp == 5 ? WS_SK : WS_SG));
            const bool gate = (grp == 3 || grp == 7);
            const float sc = (grp == 4) ? KSCALE * LOG2E : 1.0f;
#pragma unroll
            for (int ai = 0; ai < 2; ++ai)
#pragma unroll
                for (int m = 0; m < 4; ++m) {
                    const int s = (rowt + ai * HALF + m * 16) & 4095;
#pragma unroll
                    for (int bj = 0; bj < 2; ++bj) {
                        f32x4 v0 = acc[ai][bj][m][0] * sc, v1 = acc[ai][bj][m][1] * sc;
                        if (gate) {
#pragma unroll
                            for (int j = 0; j < 4; ++j) { v0[j] = silu(v0[j]); v1[j] = silu(v1[j]); }
                        }
                        u32x4 w; w.x = pk2(v0[0], v0[1]); w.y = pk2(v0[2], v0[3]); w.z = pk2(v1[0], v1[1]); w.w = pk2(v1[2], v1[3]);
                        *(u32x4*)(dst + ((size_t)(b * 8 + hb + bj) * SEQ + s) * HD + 32 * wc + 8 * fq) = w;
                    }
                }
        }
    }
};

struct Epi2 {
    const float* x; float* out; float* ssp;
    DI void operator()(const f32x4 (&acc)[2][2][4][2], const Unit& u, int wr, int wc, int fr, int fq) const {
        const int rowt = u.pm * BM + wr * 64 + fr;
#pragma unroll
        for (int ai = 0; ai < 2; ++ai)
#pragma unroll
            for (int m = 0; m < 4; ++m) {
                const int row = rowt + ai * HALF + m * 16;
                float ss = 0.f;
#pragma unroll
                for (int bj = 0; bj < 2; ++bj)
#pragma unroll
                    for (int n = 0; n < 2; ++n) {
                        const size_t o = (size_t)row * DM + u.pn * BM + bj * HALF + 32 * wc + 8 * fq + 4 * n;
                        const f32x4 xv = *(const f32x4*)(x + o);
                        const f32x4 y = xv + acc[ai][bj][m][n];
                        *(f32x4*)(out + o) = y;
                        ss += y[0] * y[0] + y[1] * y[1] + y[2] * y[2] + y[3] * y[3];
                    }
                ss += __shfl_xor(ss, 16); ss += __shfl_xor(ss, 32);
                if (fq == 0) ssp[(size_t)row * 32 + u.pn * 4 + wc] = ss;
            }
    }
};

DI void sb_unit(const Params& p, int wu, int lane) {
    unsigned char* ws = p.ws;
    const int bh = wu >> 7, tb = wu & 127, t0 = tb * 32, r = lane & 31, hh = lane >> 5, h = bh & 7, b = bh >> 3;
    const bf16_t* qp = (const bf16_t*)(ws + WS_SQ) + ((size_t)bh * SEQ + t0 + r) * HD + hh * 8;
    const bf16_t* kbase = (const bf16_t*)(ws + WS_SK) + (size_t)bh * SEQ * HD + hh * 8;
    const bf16_t* vbase = (const bf16_t*)(ws + WS_SVT) + ((size_t)bh * HD + r) * SEQ + 4 * hh;
    bf16x8 qf[8];
#pragma unroll
    for (int ks = 0; ks < 8; ++ks) qf[ks] = *(const bf16x8*)(qp + ks * 16);
    f32x16 o[4];
#pragma unroll
    for (int et = 0; et < 4; ++et)
#pragma unroll
        for (int i = 0; i < 16; ++i) o[et][i] = 0.f;
    float carry = 0.f;
    for (int s0 = t0; s0 >= 0; s0 -= 32) {
        f32x16 st;
#pragma unroll
        for (int i = 0; i < 16; ++i) st[i] = 0.f;
        const bf16_t* kp = kbase + (size_t)(s0 + r) * HD;
#pragma unroll
        for (int ks = 0; ks < 8; ++ks) { const bf16x8 kf = *(const bf16x8*)(kp + ks * 16); st = MFMA32(kf, qf[ks], st); }
        s16x4 vlo[4][2], vhi[4][2];
#pragma unroll
        for (int et = 0; et < 4; ++et)
#pragma unroll
            for (int s2 = 0; s2 < 2; ++s2) {
                const bf16_t* vp = vbase + (size_t)(et * 32) * SEQ + s0 + 16 * s2;
                vlo[et][s2] = *(const s16x4*)vp; vhi[et][s2] = *(const s16x4*)(vp + 8);
            }
        const bool diag = (s0 == t0);
        float sp[16], cs[16];
#pragma unroll
        for (int i = 0; i < 16; ++i) {
            const float z = st[i];
            float v = lg2(1.f + ex2(z));
            v = (z > 40.f) ? z : v;
            if (diag) { const int key = (i & 3) + 8 * (i >> 2) + 4 * hh; v = (key < r) ? v : 0.f; }
            sp[i] = v;
        }
        float T[4], U[4];
#pragma unroll
        for (int q = 0; q < 4; ++q) {
            cs[4 * q + 3] = sp[4 * q + 3]; cs[4 * q + 2] = cs[4 * q + 3] + sp[4 * q + 2]; cs[4 * q + 1] = cs[4 * q + 2] + sp[4 * q + 1]; cs[4 * q] = cs[4 * q + 1] + sp[4 * q];
            T[q] = cs[4 * q];
        }
#pragma unroll
        for (int q = 0; q < 4; ++q) U[q] = __shfl_xor(T[q], 32);
        float off[4];
        float run = carry;
#pragma unroll
        for (int q = 3; q >= 0; --q) { off[q] = run + (hh == 0 ? U[q] : 0.f); run += T[q] + U[q]; }
        float a[16];
#pragma unroll
        for (int i = 0; i < 16; ++i) {
            float v = ex2(st[i] - (off[i >> 2] + cs[i]));
            if (diag) { const int key = (i & 3) + 8 * (i >> 2) + 4 * hh; v = (key < r) ? v : 0.f; }
            a[i] = v;
        }
        carry = run;
#pragma unroll
        for (int s2 = 0; s2 < 2; ++s2) {
            u32x4 pw; pw.x = pk2(a[8 * s2], a[8 * s2 + 1]); pw.y = pk2(a[8 * s2 + 2], a[8 * s2 + 3]); pw.z = pk2(a[8 * s2 + 4], a[8 * s2 + 5]); pw.w = pk2(a[8 * s2 + 6], a[8 * s2 + 7]);
            const bf16x8 pf = __builtin_bit_cast(bf16x8, pw);
#pragma unroll
            for (int et = 0; et < 4; ++et) {
                const bf16x8 vf = __builtin_shufflevector(vlo[et][s2], vhi[et][s2], 0, 1, 2, 3, 4, 5, 6, 7);
                o[et] = MFMA32(vf, pf, o[et]);
            }
        }
        if (__all(carry > 150.f)) break;
    }
    float ss = 0.f;
#pragma unroll
    for (int et = 0; et < 4; ++et)
#pragma unroll
        for (int i = 0; i < 16; ++i) ss += o[et][i] * o[et][i];
    ss += __shfl_xor(ss, 32);
    const float rstd = rsqrtf(ss * (1.f / HD) + EPS);
    const int t = t0 + r;
    const bf16_t* gp = (const bf16_t*)(ws + WS_SG) + ((size_t)bh * SEQ + t) * HD;
    bf16_t* mp = (bf16_t*)(ws + WS_MIX) + ((size_t)(b * SEQ + t)) * DM + 1024 + h * HD;
#pragma unroll
    for (int et = 0; et < 4; ++et)
#pragma unroll
        for (int q = 0; q < 4; ++q) {
            const int e = et * 32 + 8 * q + 4 * hh;
            const f32x4 gn = *(const f32x4*)(p.sbg + h * HD + e);
            const u32x2 gw = *(const u32x2*)(gp + e);
            const float g0 = __uint_as_float(gw.x << 16), g1 = __uint_as_float(gw.x & 0xffff0000u), g2 = __uint_as_float(gw.y << 16), g3 = __uint_as_float(gw.y & 0xffff0000u);
            u32x2 w;
            w.x = pk2(o[et][4 * q] * rstd * gn[0] * g0, o[et][4 * q + 1] * rstd * gn[1] * g1);
            w.y = pk2(o[et][4 * q + 2] * rstd * gn[2] * g2, o[et][4 * q + 3] * rstd * gn[3] * g3);
            *(u32x2*)(mp + e) = w;
        }
}

DI void kv_unit(const Params& p, int ku, int lane) {
    unsigned char* ws = p.ws;
    const int u = ku >> 3, w = ku & 7, bh = u >> 5, c = u & 31, fr = lane & 15, fq = lane >> 4;
    const bf16_t* vt = (const bf16_t*)(ws + WS_RVT) + ((size_t)bh * HD + 16 * w + fr) * SEQ + c * 128 + fq * 8;
    const bf16_t* kt = (const bf16_t*)(ws + WS_KTZ) + ((size_t)bh * HD + fr) * SEQ + c * 128 + fq * 8;
    float* kv = (float*)(ws + WS_KV) + ((size_t)u * HD + 16 * w + fr) * HD + fq * 4;
    bf16x8 vf[4];
#pragma unroll
    for (int ks = 0; ks < 4; ++ks) vf[ks] = *(const bf16x8*)(vt + ks * 32);
#pragma unroll
    for (int dt = 0; dt < 8; ++dt) {
        f32x4 acc = {0.f, 0.f, 0.f, 0.f};
#pragma unroll
        for (int ks = 0; ks < 4; ++ks) { const bf16x8 kf = *(const bf16x8*)(kt + (size_t)(dt * 16) * SEQ + ks * 32); acc = MFMA16(kf, vf[ks], acc); }
        *(f32x4*)(kv + dt * 16) = acc;
    }
}

DI void phase_mix1(const Params& p) {
    const int wid = __builtin_amdgcn_readfirstlane(threadIdx.x >> 6), lane = threadIdx.x & 63;
    const int gw = blockIdx.x * 8 + wid, nw = gridDim.x * 8;
    for (int wu = gw; wu < 8192; wu += nw) sb_unit(p, wu, lane);
    for (int ku = gw; ku < 16384; ku += nw) kv_unit(p, ku, lane);
}

DI void phase_scan(const Params& p) {
    unsigned char* ws = p.ws;
    const float* kv = (const float*)(ws + WS_KV); bf16_t* rp = (bf16_t*)(ws + WS_RP);
    for (int idx = blockIdx.x * 512 + threadIdx.x; idx < 64 * 4096; idx += gridDim.x * 512) {
        const int bh = idx >> 12, q = idx & 4095, h = bh & 7;
        const float gc = ex2(l2gamma(h) * 128.f);
        f32x4 R = {0.f, 0.f, 0.f, 0.f};
        const size_t base = (size_t)bh * 32 * 16384 + (size_t)q * 4;
#pragma unroll 8
        for (int c = 0; c < 32; ++c) {
            u32x2 w; w.x = pk2(R[0], R[1]); w.y = pk2(R[2], R[3]);
            *(u32x2*)(rp + base + (size_t)c * 16384) = w;
            const f32x4 k4 = *(const f32x4*)(kv + base + (size_t)c * 16384);
            R = R * gc + k4;
        }
    }
}

DI void ret_unit(const Params& p, int ru, int lane) {
    unsigned char* ws = p.ws;
    const int u = ru >> 3, w = ru & 7, bh = u >> 5, c = u & 31, h = bh & 7, b = bh >> 3, fr = lane & 15, fq = lane >> 4, n0 = 16 * w;
    const float l2g = l2gamma(h);
    const bf16_t* qp = (const bf16_t*)(ws + WS_RQ) + ((size_t)bh * SEQ + c * 128 + n0 + fr) * HD + fq * 8;
    const bf16_t* kp = (const bf16_t*)(ws + WS_RK) + ((size_t)bh * SEQ + c * 128 + fr) * HD + fq * 8;
    const bf16_t* vp = (const bf16_t*)(ws + WS_RVT) + ((size_t)bh * HD + fr) * SEQ + c * 128 + fq * 4;
    const bf16_t* rpp = (const bf16_t*)(ws + WS_RP) + ((size_t)u * HD + fr) * HD + fq * 8;
    bf16x8 qf[4];
#pragma unroll
    for (int ks = 0; ks < 4; ++ks) qf[ks] = *(const bf16x8*)(qp + ks * 32);
    f32x4 st[8];
#pragma unroll
    for (int mt = 0; mt < 8; ++mt) {
        st[mt] = (f32x4){0.f, 0.f, 0.f, 0.f};
        if (mt <= w) {
#pragma unroll
            for (int ks = 0; ks < 4; ++ks) { const bf16x8 kf = *(const bf16x8*)(kp + (size_t)(mt * 16) * HD + ks * 32); st[mt] = MFMA16(kf, qf[ks], st[mt]); }
#pragma unroll
            for (int j = 0; j < 4; ++j) {
                const int dl = (n0 + fr) - (mt * 16 + fq * 4 + j);
                st[mt][j] = (dl >= 0) ? st[mt][j] * ex2(l2g * (float)dl) : 0.f;
            }
        }
    }
    f32x4 ot[8], xt[8];
#pragma unroll
    for (int et = 0; et < 8; ++et) { ot[et] = (f32x4){0.f, 0.f, 0.f, 0.f}; xt[et] = (f32x4){0.f, 0.f, 0.f, 0.f}; }
#pragma unroll
    for (int kk = 0; kk < 4; ++kk) {
        if (2 * kk <= w) {
            u32x4 pw; pw.x = pk2(st[2 * kk][0], st[2 * kk][1]); pw.y = pk2(st[2 * kk][2], st[2 * kk][3]);
            pw.z = pk2(st[2 * kk + 1][0], st[2 * kk + 1][1]); pw.w = pk2(st[2 * kk + 1][2], st[2 * kk + 1][3]);
            const bf16x8 pf = __builtin_bit_cast(bf16x8, pw);
#pragma unroll
            for (int et = 0; et < 8; ++et) {
                const bf16_t* v0 = vp + (size_t)(et * 16) * SEQ + 32 * kk;
                const s16x4 lo = *(const s16x4*)v0, hi = *(const s16x4*)(v0 + 16);
                const bf16x8 vf = __builtin_shufflevector(lo, hi, 0, 1, 2, 3, 4, 5, 6, 7);
                ot[et] = MFMA16(vf, pf, ot[et]);
            }
        }
    }
#pragma unroll
    for (int et = 0; et < 8; ++et)
#pragma unroll
        for (int ks = 0; ks < 4; ++ks) { const bf16x8 rf = *(const bf16x8*)(rpp + (size_t)(et * 16) * HD + ks * 32); xt[et] = MFMA16(rf, qf[ks], xt[et]); }
    const float xi = ex2(l2g * (float)(n0 + fr + 1));
    float sum = 0.f;
#pragma unroll
    for (int et = 0; et < 8; ++et)
#pragma unroll
        for (int j = 0; j < 4; ++j) { ot[et][j] += xi * xt[et][j]; sum += ot[et][j]; }
    sum += __shfl_xor(sum, 16); sum += __shfl_xor(sum, 32);
    const float mean = sum * (1.f / HD);
    float sq = 0.f;
#pragma unroll
    for (int et = 0; et < 8; ++et)
#pragma unroll
        for (int j = 0; j < 4; ++j) { const float d = ot[et][j] - mean; sq += d * d; }
    sq += __shfl_xor(sq, 16); sq += __shfl_xor(sq, 32);
    const float rstd = rsqrtf(sq * (1.f / HD) + EPS);
    const int s = c * 128 + n0 + fr;
    const bf16_t* gp = (const bf16_t*)(ws + WS_RG) + ((size_t)bh * SEQ + s) * HD + fq * 4;
    bf16_t* mp = (bf16_t*)(ws + WS_MIX) + ((size_t)(b * SEQ + s)) * DM + h * HD + fq * 4;
#pragma unroll
    for (int et = 0; et < 8; ++et) {
        const f32x4 gn = *(const f32x4*)(p.gng + h * HD + et * 16 + fq * 4), gb = *(const f32x4*)(p.gnb + h * HD + et * 16 + fq * 4);
        const u32x2 gw = *(const u32x2*)(gp + et * 16);
        const float g0 = __uint_as_float(gw.x << 16), g1 = __uint_as_float(gw.x & 0xffff0000u), g2 = __uint_as_float(gw.y << 16), g3 = __uint_as_float(gw.y & 0xffff0000u);
        u32x2 wv;
        wv.x = pk2(((ot[et][0] - mean) * rstd * gn[0] + gb[0]) * g0, ((ot[et][1] - mean) * rstd * gn[1] + gb[1]) * g1);
        wv.y = pk2(((ot[et][2] - mean) * rstd * gn[2] + gb[2]) * g2, ((ot[et][3] - mean) * rstd * gn[3] + gb[3]) * g3);
        *(u32x2*)(mp + et * 16) = wv;
    }
}

DI void phase_mix2(const Params& p) {
    const int wid = __builtin_amdgcn_readfirstlane(threadIdx.x >> 6), lane = threadIdx.x & 63;
    for (int ru = blockIdx.x * 8 + wid; ru < 16384; ru += gridDim.x * 8) ret_unit(p, ru, lane);
}

DI void phase_final(const Params& p) {
    const int wid = threadIdx.x >> 6, lane = threadIdx.x & 63;
    const float* ssp = (const float*)(p.ws + WS_SSP);
    for (int row = blockIdx.x * 8 + wid; row < NTOK; row += gridDim.x * 8) {
        float ss = (lane < 32) ? ssp[(size_t)row * 32 + lane] : 0.f;
        ss = wave_sum(ss);
        const float rstd = rsqrtf(ss * (1.f / DM) + EPS);
        f32x4* yr = (f32x4*)(p.out + (size_t)row * DM);
        const f32x4* gr = (const f32x4*)p.fg;
#pragma unroll
        for (int i = 0; i < 8; ++i) { f32x4 v = yr[lane + 64 * i]; const f32x4 g = gr[lane + 64 * i]; v = v * rstd * g; yr[lane + 64 * i] = v; }
    }
}

#ifndef PHM
#define PHM 127
#endif
__global__ void __launch_bounds__(512, 2) mega(Params p) {
    extern __shared__ __attribute__((aligned(16))) unsigned char shm[];
    LAS unsigned char* lds = (LAS unsigned char*)shm;
    cg::grid_group grid = cg::this_grid();
#define RUNS(k) (p.ph_lo <= (k) && (k) < p.ph_hi)
#define SYNC_AFTER(k) do { if (RUNS(k) && (k) + 1 < p.ph_hi) grid.sync(); } while (0)
    if (RUNS(0)) { if (PHM & 1) phase_prep(p, lds); }
    SYNC_AFTER(0);
    if (RUNS(1)) { if (PHM & 2) { Epi1 e; e.ws = p.ws; gemm_phase(lds, (const bf16_t*)(p.ws + WS_HB), (const bf16_t*)(p.ws + WS_WTIN), NTOK, INC, DM, e); } }
    SYNC_AFTER(1);
    if (RUNS(2)) { if (PHM & 4) phase_mix1(p); }
    SYNC_AFTER(2);
    if (RUNS(3)) { if (PHM & 8) phase_scan(p); }
    SYNC_AFTER(3);
    if (RUNS(4)) { if (PHM & 16) phase_mix2(p); }
    SYNC_AFTER(4);
    if (RUNS(5)) { if (PHM & 32) { Epi2 e; e.x = p.x; e.out = p.out; e.ssp = (float*)(p.ws + WS_SSP); gemm_phase(lds, (const bf16_t*)(p.ws + WS_MIX), (const bf16_t*)(p.ws + WS_WTOUT), NTOK, DM, DM, e); } }
    SYNC_AFTER(5);
    if (RUNS(6)) { if (PHM & 64) phase_final(p); }
}

constexpr int LDS_BYTES = 131072;
#ifndef N_LAUNCH_MODE
#define N_LAUNCH_MODE 7
#endif

extern "C" void kernel_launch(void* const* d_in, const int* in_sizes, int n_in, void* d_out, int out_size, void* d_ws, size_t ws_size, hipStream_t stream) {
    static int grid = 0;
    if (grid == 0) {
        if (ws_size < WS_END) { fprintf(stderr, "kernel_launch: workspace too small (%zu < %zu)\n", ws_size, (size_t)WS_END); grid = -1; return; }
        int dev = 0, cus = 0, per_cu = 0;
        hipGetDevice(&dev);
        hipDeviceGetAttribute(&cus, hipDeviceAttributeMultiprocessorCount, dev);
        if (hipFuncSetAttribute((const void*)mega, hipFuncAttributeMaxDynamicSharedMemorySize, LDS_BYTES) != hipSuccess) { fprintf(stderr, "kernel_launch: hipFuncSetAttribute failed\n"); grid = -1; return; }
        if (hipOccupancyMaxActiveBlocksPerMultiprocessor(&per_cu, (const void*)mega, 512, LDS_BYTES) != hipSuccess || per_cu < 1) per_cu = 1;
        (void)hipGetLastError();
        grid = cus * 1;
        if (grid <= 0) grid = 256;
    }
    if (grid < 0) return;
    Params p{};
    p.x = (const float*)d_in[0]; p.ng = (const float*)d_in[1]; p.w_in = (const float*)d_in[2]; p.gng = (const float*)d_in[3]; p.gnb = (const float*)d_in[4];
    p.sbg = (const float*)d_in[5]; p.w_out = (const float*)d_in[6]; p.fg = (const float*)d_in[7];
    p.out = (float*)d_out; p.ws = (unsigned char*)d_ws;
#if N_LAUNCH_MODE == 1
    p.ph_lo = 0; p.ph_hi = 7;
    void* args[] = {&p};
    hipError_t e = hipLaunchCooperativeKernel((const void*)mega, dim3(grid), dim3(512), args, LDS_BYTES, stream);
    if (e != hipSuccess) fprintf(stderr, "cooperative launch failed: %s (grid %d)\n", hipGetErrorString(e), grid);
#else
    for (int ph = 0; ph < 7; ++ph) {
        p.ph_lo = ph; p.ph_hi = ph + 1;
        hipLaunchKernelGGL(mega, dim3(grid), dim3(512), LDS_BYTES, stream, p);
    }
#endif
}
```

```cpp
#include <hip/hip_runtime.h>
#include <hip/hip_cooperative_groups.h>
#include <cstdio>
namespace cg = cooperative_groups;

#define LAS __attribute__((address_space(3)))
#define DI __device__ __forceinline__
typedef unsigned short bf16_t;
typedef short bf16x8 __attribute__((ext_vector_type(8)));
typedef short s16x4 __attribute__((ext_vector_type(4)));
typedef float f32x2 __attribute__((ext_vector_type(2)));
typedef float f32x4 __attribute__((ext_vector_type(4)));
typedef float f32x16 __attribute__((ext_vector_type(16)));
typedef unsigned u32x2 __attribute__((ext_vector_type(2)));
typedef unsigned u32x4 __attribute__((ext_vector_type(4)));
typedef __bf16 bf16v2 __attribute__((ext_vector_type(2)));

constexpr int SEQ = 4096, DM = 2048, NTOK = 32768, INC = 8192, HD = 128;
constexpr float EPS = 1e-6f;
constexpr float LOG2E = 1.4426950408889634f;
constexpr float KSCALE = 0.08838834764831845f;

constexpr size_t SZ64 = 67108864ull;
constexpr size_t WS_HB = 0;
constexpr size_t WS_MIX = 0;
constexpr size_t WS_WTIN = 134217728ull;
constexpr size_t WS_WTOUT = WS_WTIN + 33554432ull;
constexpr size_t WS_RQ = WS_WTOUT + 8388608ull;
constexpr size_t WS_RK = WS_RQ + SZ64;
constexpr size_t WS_KTZ = WS_RK + SZ64;
constexpr size_t WS_RVT = WS_KTZ + SZ64;
constexpr size_t WS_RG = WS_RVT + SZ64;
constexpr size_t WS_SQ = WS_RG + SZ64;
constexpr size_t WS_SK = WS_SQ + SZ64;
constexpr size_t WS_SVT = WS_SK + SZ64;
constexpr size_t WS_SG = WS_SVT + SZ64;
constexpr size_t WS_KV = WS_SG + SZ64;
constexpr size_t WS_RP = WS_KV + 134217728ull;
constexpr size_t WS_ROPE = WS_RP + SZ64;
constexpr size_t WS_SSP = WS_ROPE + 2097152ull;
constexpr size_t WS_CNT = WS_SSP + 4194304ull;
constexpr size_t WS_BAR = WS_CNT + 4096ull;
constexpr size_t WS_END = WS_BAR + 16384ull;

struct Params {
    const float* x; const float* ng; const float* w_in; const float* gng; const float* gnb; const float* sbg; const float* w_out; const float* fg;
    float* out; unsigned char* ws; int ph_lo; int ph_hi;
};

DI unsigned pk2(float lo, float hi) { f32x2 v = {lo, hi}; bf16v2 r = __builtin_convertvector(v, bf16v2); return __builtin_bit_cast(unsigned, r); }
DI bf16_t bf1(float x) { return (bf16_t)(pk2(x, x) & 0xffffu); }
DI float ex2(float x) { return __builtin_amdgcn_exp2f(x); }
DI float lg2(float x) { return __builtin_amdgcn_logf(x); }
DI float l2gamma(int h) {
    const float x = __uint_as_float((unsigned)(127 - 5 - h) << 23);
    const float s = x * (1.f + x * (0.5f + x * (0.33333334f + x * (0.25f + x * (0.2f + x * 0.16666667f)))));
    return -s * LOG2E;
}
DI float silu(float v) { return v * __builtin_amdgcn_rcpf(1.f + ex2(-v * LOG2E)); }
DI float wave_sum(float v) {
#pragma unroll
    for (int o = 32; o >= 1; o >>= 1) v += __shfl_xor(v, o);
    return v;
}
#define MFMA16(a, b, c) __builtin_amdgcn_mfma_f32_16x16x32_bf16((a), (b), (c), 0, 0, 0)
#define MFMA32(a, b, c) __builtin_amdgcn_mfma_f32_32x32x16_bf16((a), (b), (c), 0, 0, 0)

DI int dst_row_in(int nsrc) {
    const int pn = nsrc >> 8, off = nsrc & 255, grp = pn >> 2, bj = off >> 7, cc = off & 127;
    int rho;
    if (grp < 2) { const int n = cc >> 6, a = cc & 63; rho = 32 * (a >> 4) + 16 * n + (a & 15); }
    else { const int wc = cc >> 5, fq = (cc >> 3) & 3, n = (cc >> 2) & 1, j = cc & 3; rho = 32 * wc + 16 * n + 4 * fq + j; }
    return pn * 256 + bj * 128 + rho;
}
DI int dst_row_out(int nsrc) {
    const int pn = nsrc >> 8, off = nsrc & 255, bj = off >> 7, cc = off & 127;
    const int wc = cc >> 5, fq = (cc >> 3) & 3, n = (cc >> 2) & 1, j = cc & 3;
    return pn * 256 + bj * 128 + 32 * wc + 16 * n + 4 * fq + j;
}


#define XB_TMO      128
#define XB_XCNT(j)  (256  + 64 * (j))
#define XB_XSUB(j)  (1280 + 64 * (j))
#define XB_XGEN(j)  (2304 + 64 * (j))
#define XB_TOP      3328
#define XB_TOPGEN   3392
#define XCD_BAR_WORDS 3456
#define XB_SPIN_CAP (1u << 22)
DI unsigned xb_ld(unsigned* p)              { return __hip_atomic_load(p, __ATOMIC_RELAXED, __HIP_MEMORY_SCOPE_AGENT); }
DI unsigned xb_add(unsigned* p, unsigned v) { return __hip_atomic_fetch_add(p, v, __ATOMIC_RELAXED, __HIP_MEMORY_SCOPE_AGENT); }
DI unsigned xb_xcc_id() { return (unsigned)__builtin_amdgcn_s_getreg((3 << 11) | 20) & 0xFu; }
#define XB_SPIN(cond, bar) do { unsigned _sp = 0; while (cond) { __builtin_amdgcn_s_sleep(1); \
    if ((++_sp & 255u) == 0u) { if (xb_ld(&(bar)[XB_TMO])) break; if (_sp > XB_SPIN_CAP) { atomicAdd(&(bar)[XB_TMO], 1u); break; } } } } while (0)
struct XcdBarrier { unsigned* bar; unsigned x; volatile LAS unsigned* st; };
DI XcdBarrier xcd_barrier_post(unsigned* bar, volatile LAS unsigned* st) {
    XcdBarrier b; b.bar = bar; b.x = xb_xcc_id(); b.st = st;
    if (threadIdx.x == 0) (void)xb_add(&bar[XB_XCNT(b.x)], 1u);
    return b;
}
DI void xcd_barrier_complete(unsigned* bar, unsigned x, unsigned& nloc, unsigned& nx) {
    const unsigned G = gridDim.x * gridDim.y * gridDim.z;
    unsigned sum, cnt, mine, sp = 0u;
    for (;;) {
        sum = 0u; cnt = 0u; mine = 0u;
#pragma unroll
        for (unsigned j = 0; j < 16; ++j) { const unsigned c = xb_ld(&bar[XB_XCNT(j)]); sum += c; cnt += (c > 0u) ? 1u : 0u; mine = (j == x) ? c : mine; }
        if (sum == G) break;
        __builtin_amdgcn_s_sleep(1);
        if ((++sp & 255u) == 0u) { if (xb_ld(&bar[XB_TMO])) break; if (sp > XB_SPIN_CAP) { atomicAdd(&bar[XB_TMO], 1u); break; } }
    }
    nloc = mine > 0u ? mine : 1u; nx = cnt > 0u ? cnt : 1u;
}
DI void xcd_barrier(const XcdBarrier& b) {
    asm volatile("s_waitcnt vmcnt(0)" ::: "memory");
    __syncthreads();
    if (threadIdx.x == 0) {
        unsigned* bar = b.bar;
        __builtin_amdgcn_s_waitcnt(0);
        unsigned nloc = b.st[0], nx = b.st[1];
        if (nloc == 0u) { xcd_barrier_complete(bar, b.x, nloc, nx); b.st[0] = nloc; b.st[1] = nx; }
        const unsigned old = xb_add(&bar[XB_XSUB(b.x)], 1u);
        const unsigned gen = old / nloc;
        if (old + 1u == (gen + 1u) * nloc) {
            __builtin_amdgcn_fence(__ATOMIC_RELEASE, "agent");
            asm volatile("s_waitcnt vmcnt(0)" ::: "memory");
            const unsigned og = xb_add(&bar[XB_TOP], 1u);
            const unsigned tg = og / nx;
            if (og + 1u == (tg + 1u) * nx) xb_add(&bar[XB_TOPGEN], 1u);
            else XB_SPIN(xb_ld(&bar[XB_TOPGEN]) == tg, bar);
            __builtin_amdgcn_fence(__ATOMIC_ACQUIRE, "agent");
            xb_add(&bar[XB_XGEN(b.x)], 1u);
            asm volatile("s_waitcnt vmcnt(0)" ::: "memory");
        } else {
            XB_SPIN(xb_ld(&bar[XB_XGEN(b.x)]) == gen, bar);
            __builtin_amdgcn_fence(__ATOMIC_ACQUIRE, "agent");
            asm volatile("s_waitcnt vmcnt(0)" ::: "memory");
        }
    }
    __syncthreads();
}

DI void phase_prep(const Params& p, LAS unsigned char* lds) {
    const int tid = threadIdx.x, wid = tid >> 6, lane = tid & 63;
    unsigned char* ws = p.ws;
    if (blockIdx.x == 0 && tid < 128) ((unsigned*)(ws + WS_CNT))[tid] = 0u;
    {
        bf16_t* hb = (bf16_t*)(ws + WS_HB);
        for (int row = (blockIdx.x * 8 + wid) * 2; row < NTOK; row += gridDim.x * 16) {
            const f32x4* xr = (const f32x4*)(p.x + (size_t)row * DM);
            f32x4 v[2][8]; float ss[2] = {0.f, 0.f};
#pragma unroll
            for (int rr = 0; rr < 2; ++rr)
#pragma unroll
                for (int i = 0; i < 8; ++i) v[rr][i] = __builtin_nontemporal_load(xr + rr * (DM / 4) + lane + 64 * i);
#pragma unroll
            for (int rr = 0; rr < 2; ++rr) {
#pragma unroll
                for (int i = 0; i < 8; ++i) ss[rr] += v[rr][i][0] * v[rr][i][0] + v[rr][i][1] * v[rr][i][1] + v[rr][i][2] * v[rr][i][2] + v[rr][i][3] * v[rr][i][3];
                ss[rr] = wave_sum(ss[rr]);
            }
#pragma unroll
            for (int rr = 0; rr < 2; ++rr) {
                const float rstd = rsqrtf(ss[rr] * (1.f / DM) + EPS);
#pragma unroll
                for (int i = 0; i < 8; ++i) {
                    u32x2 w; w.x = pk2(v[rr][i][0] * rstd, v[rr][i][1] * rstd); w.y = pk2(v[rr][i][2] * rstd, v[rr][i][3] * rstd);
                    *(u32x2*)(hb + (size_t)(row + rr) * DM + (lane + 64 * i) * 4) = w;
                }
            }
        }
    }
    {
        bf16_t* wtin = (bf16_t*)(ws + WS_WTIN); bf16_t* wtout = (bf16_t*)(ws + WS_WTOUT);
        for (int g4 = blockIdx.x; g4 < (4096 + 1024) / 4; g4 += gridDim.x) {
            f32x4 v[4][2]; float gg[4][2];
#pragma unroll
            for (int q = 0; q < 4; ++q) {
                const int t = g4 * 4 + q;
                const bool isin = t < 4096;
                const int tt = isin ? t : t - 4096;
                const int ncols = isin ? INC : DM;
                const int ntn = ncols / 64;
                const int kt = tt / ntn, nt = tt % ntn, k0 = kt * 64, n0 = nt * 64;
                const float* src = isin ? p.w_in : p.w_out;
#pragma unroll
                for (int ps = 0; ps < 2; ++ps) {
                    const int i = (tid >> 4) + 32 * ps, c4 = (tid & 15) * 4;
                    v[q][ps] = __builtin_nontemporal_load((const f32x4*)(src + (size_t)(k0 + i) * ncols + n0 + c4));
                    gg[q][ps] = isin ? p.ng[k0 + i] : 1.f;
                }
            }
#pragma unroll
            for (int q = 0; q < 4; ++q) {
                LAS float* tile = (LAS float*)(lds + q * 16640);
#pragma unroll
                for (int ps = 0; ps < 2; ++ps) {
                    const int i = (tid >> 4) + 32 * ps, c4 = (tid & 15) * 4;
                    const float g = gg[q][ps];
                    tile[i * 65 + c4 + 0] = v[q][ps][0] * g; tile[i * 65 + c4 + 1] = v[q][ps][1] * g; tile[i * 65 + c4 + 2] = v[q][ps][2] * g; tile[i * 65 + c4 + 3] = v[q][ps][3] * g;
                }
            }
            __syncthreads();
#pragma unroll
            for (int q = 0; q < 4; ++q) {
                const int t = g4 * 4 + q;
                const bool isin = t < 4096;
                const int tt = isin ? t : t - 4096;
                const int ntn = (isin ? INC : DM) / 64;
                const int kt = tt / ntn, nt = tt % ntn, k0 = kt * 64, n0 = nt * 64;
                LAS float* tile = (LAS float*)(lds + q * 16640);
                const int nl = tid >> 3, ks = tid & 7;
                float f[8];
#pragma unroll
                for (int j = 0; j < 8; ++j) f[j] = tile[(ks * 8 + j) * 65 + nl];
                u32x4 w; w.x = pk2(f[0], f[1]); w.y = pk2(f[2], f[3]); w.z = pk2(f[4], f[5]); w.w = pk2(f[6], f[7]);
                const int dr = isin ? dst_row_in(n0 + nl) : dst_row_out(n0 + nl);
                bf16_t* dst = (isin ? wtin : wtout) + (size_t)dr * DM + k0 + ks * 8;
                *(u32x4*)dst = w;
            }
            __syncthreads();
        }
    }
}

constexpr int BM = 256, BK = 64, HALF = 128, HTB = HALF * BK * 2, NXCD = 8, WGM = 8;
__host__ __device__ __forceinline__ int lds_byte(int r, int c) { const int st = (r >> 4) * 2 + (c >> 5), rr = r & 15, cc = c & 31, ob = rr * 64 + cc * 2; return st * 1024 + (ob ^ (((ob >> 9) & 1) << 5)); }
__host__ __device__ __forceinline__ void stage_rc(int b, int& R, int& C) { const int st = b / 1024, sb = b % 1024, swz = sb ^ (((sb >> 9) & 1) << 5); R = (st >> 1) * 16 + swz / 64; C = (st & 1) * 32 + (swz % 64) / 2; }
struct Unit { int pm, pn; };
DI bool next_unit(int i, int nM, int nN, Unit& u, int mode) {
    if (mode == 1) {
        if (i >= 4) return false;
        const int c = blockIdx.x, x = c & 7, j = c >> 3;
        u.pm = (i * 8 + x) * 4 + (j >> 3); u.pn = j & 7; return true;
    }
    const int nwg = nM * nN; const long L = (long)i * gridDim.x + blockIdx.x; if (L >= nwg) return false;
    int wgid = (int)L; { const int q = nwg / NXCD, r = nwg % NXCD, xcd = wgid % NXCD, off = wgid / NXCD; wgid = (xcd < r ? xcd * (q + 1) : r * (q + 1) + (xcd - r) * q) + off; }
    const int nig = WGM * nN, gid = wgid / nig, fm = gid * WGM, gsz = (nM - fm) < WGM ? (nM - fm) : WGM;
    u.pm = fm + ((wgid % nig) % gsz); u.pn = (wgid % nig) / gsz; return true;
}

template <class Epi>
DI void gemm_phase(LAS unsigned char* lds, const bf16_t* gA, const bf16_t* gBt, int M, int N, int K, const Epi& E, int mode) {
    const int tid = threadIdx.x, wid = __builtin_amdgcn_readfirstlane(tid >> 6), lane = tid & 63, wr = wid >> 2, wc = wid & 3, fr = lane & 15, fq = lane >> 4;
    const int nt = K / BK, nM = M / BM, nN = N / BM;
    unsigned voffA[2], voffB[2];
#pragma unroll
    for (int i = 0; i < 2; ++i) { int R, C; stage_rc(tid * 16 + i * 8192, R, C); const int Rp = (R & 64) | ((R & 15) << 2) | ((R >> 4) & 3);
        voffA[i] = (unsigned)(Rp * K + C) * 2u; voffB[i] = (unsigned)(R * K + C) * 2u; }
    const size_t kstep = (size_t)(BK * 2);
    const size_t hstep = (size_t)HALF * K * 2;
    const size_t tstep = 2 * hstep;
    const unsigned ldsw = (unsigned)wid * 1024u;
    const int aoff = lds_byte(wr * 64 + fr, fq * 8), boff = lds_byte(wc * 32 + fr, fq * 8);
#define PG8_SA(b, h) (((b) * 2 + (h)) * HTB)
#define PG8_SB(b, h) ((4 + (b) * 2 + (h)) * HTB)
#define PG8_STAGE(bufoff, gbase, voff) do { _Pragma("unroll") for (int _i = 0; _i < 2; ++_i) \
        __builtin_amdgcn_global_load_lds((const unsigned*)((const char*)(gbase) + (voff)[_i]), (LAS unsigned*)(lds + (bufoff) + ldsw + _i * 8192), 16, 0, 0); } while (0)
#define PG8_LDA(dst, b, h) do { _Pragma("unroll") for (int m = 0; m < 4; ++m) _Pragma("unroll") for (int k = 0; k < 2; ++k) dst[m][k] = *(const LAS bf16x8*)(lds + PG8_SA(b, h) + aoff + m * 2048 + k * 1024); } while (0)
#define PG8_LDB(dst, b, h) do { _Pragma("unroll") for (int n = 0; n < 2; ++n) _Pragma("unroll") for (int k = 0; k < 2; ++k) dst[n][k] = *(const LAS bf16x8*)(lds + PG8_SB(b, h) + boff + n * 2048 + k * 1024); } while (0)
#define PG8_MMA(ai, bj, At, Bt) do { __builtin_amdgcn_s_setprio(1); _Pragma("unroll") for (int m = 0; m < 4; ++m) _Pragma("unroll") for (int n = 0; n < 2; ++n) _Pragma("unroll") for (int k = 0; k < 2; ++k) \
        acc[ai][bj][m][n] = __builtin_amdgcn_mfma_f32_16x16x32_bf16(Bt[n][k], At[m][k], acc[ai][bj][m][n], 0, 0, 0); __builtin_amdgcn_s_setprio(0); } while (0)
#define PG8_WAIT_V(n) asm volatile("s_waitcnt vmcnt(" #n ")" ::: "memory")
#define PG8_WAIT_L(n) asm volatile("s_waitcnt lgkmcnt(" #n ")" ::: "memory")
#define PG8_BAR __builtin_amdgcn_s_barrier()
#define PG8_SCHED __builtin_amdgcn_sched_barrier(0)
    Unit cur, nxt; int ui = 0;
    if (!next_unit(0, nM, nN, cur, mode)) return;
    f32x4 acc[2][2][4][2];
    E.init(acc, cur, wr, wc, fr, fq);
    bf16x8 At[4][2], B0[2][2], B1[2][2];
    const char* cA = (const char*)gA + (size_t)cur.pm * tstep; const char* cB = (const char*)gBt + (size_t)cur.pn * tstep;
    PG8_STAGE(PG8_SB(0, 0), cB, voffB); PG8_STAGE(PG8_SA(0, 0), cA, voffA); PG8_STAGE(PG8_SB(0, 1), cB + hstep, voffB); PG8_STAGE(PG8_SA(0, 1), cA + hstep, voffA);
    if (wr == 1) PG8_BAR;
    PG8_WAIT_V(4); PG8_BAR;
    PG8_STAGE(PG8_SB(1, 0), cB + kstep, voffB); PG8_STAGE(PG8_SA(1, 0), cA + kstep, voffA); PG8_STAGE(PG8_SB(1, 1), cB + hstep + kstep, voffB);
    PG8_WAIT_V(6); PG8_BAR;
    for (;;) {
        const bool has_next = next_unit(ui + 1, nM, nN, nxt, mode);
        const char* nA = has_next ? (const char*)gA + (size_t)nxt.pm * tstep : cA; const char* nB = has_next ? (const char*)gBt + (size_t)nxt.pn * tstep : cB;
        for (int t = 0; t < nt; t += 2) {
            const bool last = (t == nt - 2);
            const char* a1 = cA + (size_t)(t + 1) * kstep;
            const char* a2 = last ? nA : cA + (size_t)(t + 2) * kstep; const char* b2 = last ? nB : cB + (size_t)(t + 2) * kstep;
            const char* a3 = a2 + kstep; const char* b3 = b2 + kstep;
            PG8_LDB(B0, 0, 0); PG8_SCHED; PG8_LDA(At, 0, 0); PG8_STAGE(PG8_SA(1, 1), a1 + hstep, voffA);
            PG8_WAIT_L(8); PG8_BAR; PG8_WAIT_L(0); PG8_MMA(0, 0, At, B0); PG8_BAR; PG8_SCHED;
            PG8_LDB(B1, 0, 1); PG8_STAGE(PG8_SB(0, 0), b2, voffB);
            PG8_BAR; PG8_WAIT_L(0); PG8_MMA(0, 1, At, B1); PG8_BAR;
            PG8_LDA(At, 0, 1); PG8_STAGE(PG8_SA(0, 0), a2, voffA);
            PG8_BAR; PG8_WAIT_L(0); PG8_MMA(1, 0, At, B0); PG8_BAR; PG8_SCHED;
            PG8_STAGE(PG8_SB(0, 1), b2 + hstep, voffB);
            PG8_WAIT_V(6); PG8_BAR; PG8_MMA(1, 1, At, B1); PG8_BAR;
            PG8_LDB(B0, 1, 0); PG8_SCHED; PG8_LDA(At, 1, 0); PG8_STAGE(PG8_SA(0, 1), a2 + hstep, voffA);
            PG8_WAIT_L(8); PG8_BAR; PG8_WAIT_L(0); PG8_MMA(0, 0, At, B0); PG8_BAR; PG8_SCHED;
            PG8_LDB(B1, 1, 1); PG8_STAGE(PG8_SB(1, 0), b3, voffB);
            PG8_BAR; PG8_WAIT_L(0); PG8_MMA(0, 1, At, B1); PG8_BAR;
            PG8_LDA(At, 1, 1); PG8_STAGE(PG8_SA(1, 0), a3, voffA);
            PG8_BAR; PG8_WAIT_L(0); PG8_MMA(1, 0, At, B0); PG8_BAR; PG8_SCHED;
            PG8_STAGE(PG8_SB(1, 1), b3 + hstep, voffB);
            PG8_WAIT_V(6); PG8_BAR; PG8_MMA(1, 1, At, B1); PG8_BAR;
        }
        if (Epi::REALIGN) { if (wr == 0) PG8_BAR; }
        E(acc, cur, wr, wc, fr, fq);
        if (Epi::REALIGN) { if (wr == 1) PG8_BAR; }
        if (!has_next) break;
        E.init(acc, nxt, wr, wc, fr, fq);
        cur = nxt; cA = nA; cB = nB; ++ui;
    }
    PG8_WAIT_V(0);
    if (wr == 0) PG8_BAR;
    PG8_BAR;
#undef PG8_SA
#undef PG8_SB
#undef PG8_STAGE
#undef PG8_LDA
#undef PG8_LDB
#undef PG8_MMA
#undef PG8_WAIT_V
#undef PG8_WAIT_L
#undef PG8_BAR
#undef PG8_SCHED
}

struct Epi1 {
    static constexpr bool REALIGN = false;
    unsigned char* ws;
    DI void init(f32x4 (&acc)[2][2][4][2], const Unit&, int, int, int, int) const {
#pragma unroll
        for (int a = 0; a < 2; ++a)
#pragma unroll
            for (int b = 0; b < 2; ++b)
#pragma unroll
                for (int m = 0; m < 4; ++m)
#pragma unroll
                    for (int n = 0; n < 2; ++n) acc[a][b][m][n] = (f32x4){0.f, 0.f, 0.f, 0.f};
    }
    DI void operator()(f32x4 (&acc)[2][2][4][2], const Unit& u, int wr, int wc, int fr, int fq) const {
        const int grp = u.pn >> 2, hb = (u.pn & 3) * 2;
        const int rowt = u.pm * BM + wr * 64 + 4 * fr;
        const int b = rowt >> 12;
        const int sl0 = wr * 64 + 4 * fr;
        if (grp < 2) {
            bf16_t* dst = (bf16_t*)(ws + (grp == 0 ? WS_RQ : WS_RK));
            bf16_t* ktz = (bf16_t*)(ws + WS_KTZ);
            const int a0 = 16 * wc + 4 * fq;
            float invrev[4];
#pragma unroll
            for (int j = 0; j < 4; ++j) invrev[j] = ex2(-(float)(a0 + j) * (13.287712379549449f / 64.f)) * 0.15915494309189535f;
#pragma unroll
            for (int ai = 0; ai < 2; ++ai) {
                const int c = (u.pm * 2 + ai) & 31;
                f32x4 cc[4], sn[4];
#pragma unroll
                for (int m = 0; m < 4; ++m) {
                    const float sf = (float)((rowt + ai * HALF + m) & 4095);
#pragma unroll
                    for (int j = 0; j < 4; ++j) {
                        const float rv = sf * invrev[j];
                        const float fr_ = rv - __builtin_floorf(rv);
                        cc[m][j] = __builtin_amdgcn_cosf(fr_); sn[m][j] = __builtin_amdgcn_sinf(fr_);
                    }
                }
#pragma unroll
                for (int bj = 0; bj < 2; ++bj) {
                    const int head = hb + bj;
                    f32x4 o1[4], o2[4];
#pragma unroll
                    for (int m = 0; m < 4; ++m) {
                        const int s = (rowt + ai * HALF + m) & 4095;
                        const f32x4 c4 = cc[m], s4 = sn[m];
                        const f32x4 v1 = acc[ai][bj][m][0], v2 = acc[ai][bj][m][1];
                        o1[m] = v1 * c4 - v2 * s4; o2[m] = v1 * s4 + v2 * c4;
                        if (grp == 1) { o1[m] *= KSCALE; o2[m] *= KSCALE; }
                        bf16_t* rp = dst + ((size_t)(b * 8 + head) * SEQ + s) * HD + a0;
                        u32x2 w1, w2; w1.x = pk2(o1[m][0], o1[m][1]); w1.y = pk2(o1[m][2], o1[m][3]); w2.x = pk2(o2[m][0], o2[m][1]); w2.y = pk2(o2[m][2], o2[m][3]);
                        *(u32x2*)rp = w1; *(u32x2*)(rp + 64) = w2;
                    }
                    if (grp == 1) {
                        const float l2g = l2gamma(head);
                        float z[4];
#pragma unroll
                        for (int m = 0; m < 4; ++m) z[m] = ex2(l2g * (float)(127 - (sl0 + m)));
                        bf16_t* kt = ktz + (((size_t)(b * 8 + head) * 32 + c) * HD + a0) * 128 + sl0;
#pragma unroll
                        for (int j = 0; j < 4; ++j) {
                            u32x2 w1, w2;
                            w1.x = pk2(o1[0][j] * z[0], o1[1][j] * z[1]); w1.y = pk2(o1[2][j] * z[2], o1[3][j] * z[3]);
                            w2.x = pk2(o2[0][j] * z[0], o2[1][j] * z[1]); w2.y = pk2(o2[2][j] * z[2], o2[3][j] * z[3]);
                            *(u32x2*)(kt + j * 128) = w1; *(u32x2*)(kt + (64 + j) * 128) = w2;
                        }
                    }
                }
            }
        } else if (grp == 2 || grp == 6) {
            bf16_t* dst = (bf16_t*)(ws + (grp == 2 ? WS_RVT : WS_SVT));
#pragma unroll
            for (int ai = 0; ai < 2; ++ai) {
                const int c = (u.pm * 2 + ai) & 31;
#pragma unroll
                for (int bj = 0; bj < 2; ++bj) {
                    bf16_t* vt = (grp == 2) ? dst + (((size_t)(b * 8 + hb + bj) * 32 + c) * HD + 32 * wc + 8 * fq) * 128 + sl0
                                            : dst + (((size_t)(b * 8 + hb + bj) * 128 + c * 4 + (sl0 >> 5)) * HD + 32 * wc + 8 * fq) * 32 + (sl0 & 31);
                    const int rs = (grp == 2) ? 128 : 32;
#pragma unroll
                    for (int n = 0; n < 2; ++n)
#pragma unroll
                        for (int j = 0; j < 4; ++j) {
                            u32x2 w; w.x = pk2(acc[ai][bj][0][n][j], acc[ai][bj][1][n][j]); w.y = pk2(acc[ai][bj][2][n][j], acc[ai][bj][3][n][j]);
                            *(u32x2*)(vt + (4 * n + j) * rs) = w;
                        }
                }
            }
        } else {
            bf16_t* dst = (bf16_t*)(ws + (grp == 3 ? WS_RG : grp == 4 ? WS_SQ : grp == 5 ? WS_SK : WS_SG));
            const bool gate = (grp == 3 || grp == 7);
            const float sc = (grp == 4) ? KSCALE * LOG2E : 1.0f;
#pragma unroll
            for (int ai = 0; ai < 2; ++ai)
#pragma unroll
                for (int m = 0; m < 4; ++m) {
                    const int s = (rowt + ai * HALF + m) & 4095;
#pragma unroll
                    for (int bj = 0; bj < 2; ++bj) {
                        f32x4 v0 = acc[ai][bj][m][0] * sc, v1 = acc[ai][bj][m][1] * sc;
                        if (gate) {
#pragma unroll
                            for (int j = 0; j < 4; ++j) { v0[j] = silu(v0[j]); v1[j] = silu(v1[j]); }
                        }
                        u32x4 w; w.x = pk2(v0[0], v0[1]); w.y = pk2(v0[2], v0[3]); w.z = pk2(v1[0], v1[1]); w.w = pk2(v1[2], v1[3]);
                        *(u32x4*)(dst + ((size_t)(b * 8 + hb + bj) * SEQ + s) * HD + 32 * wc + 8 * fq) = w;
                    }
                }
        }
    }
};

struct Epi2 {
    static constexpr bool REALIGN = false;
    const float* x; float* out; float* ssp;
    DI void init(f32x4 (&acc)[2][2][4][2], const Unit&, int, int, int, int) const {
#pragma unroll
        for (int a = 0; a < 2; ++a)
#pragma unroll
            for (int b = 0; b < 2; ++b)
#pragma unroll
                for (int m = 0; m < 4; ++m)
#pragma unroll
                    for (int n = 0; n < 2; ++n) acc[a][b][m][n] = (f32x4){0.f, 0.f, 0.f, 0.f};
    }
    DI void operator()(f32x4 (&acc)[2][2][4][2], const Unit& u, int wr, int wc, int fr, int fq) const {
        const int rowt = u.pm * BM + wr * 64 + 4 * fr;
#pragma unroll
        for (int ai = 0; ai < 2; ++ai) {
            f32x4 xv[4][2][2];
#pragma unroll
            for (int m = 0; m < 4; ++m)
#pragma unroll
                for (int bj = 0; bj < 2; ++bj)
#pragma unroll
                    for (int n = 0; n < 2; ++n)
                        xv[m][bj][n] = *(const f32x4*)(x + (size_t)(rowt + ai * HALF + m) * DM + u.pn * BM + bj * HALF + 32 * wc + 8 * fq + 4 * n);
#pragma unroll
            for (int m = 0; m < 4; ++m) {
                const int row = rowt + ai * HALF + m;
                float ss = 0.f;
#pragma unroll
                for (int bj = 0; bj < 2; ++bj)
#pragma unroll
                    for (int n = 0; n < 2; ++n) {
                        const size_t o = (size_t)row * DM + u.pn * BM + bj * HALF + 32 * wc + 8 * fq + 4 * n;
                        const f32x4 y = xv[m][bj][n] + acc[ai][bj][m][n];
                        *(f32x4*)(out + o) = y;
                        ss += y[0] * y[0] + y[1] * y[1] + y[2] * y[2] + y[3] * y[3];
                    }
                ss += __shfl_xor(ss, 16); ss += __shfl_xor(ss, 32);
                if (fq == 0) ssp[(size_t)row * 32 + u.pn * 4 + wc] = ss;
            }
        }
    }
};


struct Epi2F {
    static constexpr bool REALIGN = true;
    const float* x; float* out; float* ssp; unsigned* cnt; const float* fg; LAS float* xl;
    DI void init(f32x4 (&acc)[2][2][4][2], const Unit& u, int wr, int wc, int fr, int fq) const {
        const float* xp = x + (size_t)(u.pm * BM + wr * 64 + 4 * fr) * DM + u.pn * BM + 32 * wc + 8 * fq;
#pragma unroll
        for (int ai = 0; ai < 2; ++ai)
#pragma unroll
            for (int bj = 0; bj < 2; ++bj)
#pragma unroll
                for (int m = 0; m < 4; ++m)
#pragma unroll
                    for (int n = 0; n < 2; ++n) acc[ai][bj][m][n] = __builtin_nontemporal_load((const f32x4*)(xp + (size_t)(ai * HALF + m) * DM + bj * HALF + 4 * n));
    }
    DI void operator()(f32x4 (&acc)[2][2][4][2], const Unit& u, int wr, int wc, int fr, int fq) const {
        const int tid = threadIdx.x;
        const int rl = wr * 64 + 4 * fr;
        const int rowt = u.pm * BM + rl;
        const int colt = u.pn * BM + 32 * wc + 8 * fq;
#pragma unroll
        for (int ai = 0; ai < 2; ++ai)
#pragma unroll
            for (int m = 0; m < 4; ++m) {
                float ss = 0.f;
#pragma unroll
                for (int bj = 0; bj < 2; ++bj)
#pragma unroll
                    for (int n = 0; n < 2; ++n) { const f32x4 y = acc[ai][bj][m][n]; ss += y[0] * y[0] + y[1] * y[1] + y[2] * y[2] + y[3] * y[3]; }
                ss += __shfl_xor(ss, 16); ss += __shfl_xor(ss, 32);
                if (fq == 0) xl[wc * 256 + rl + ai * HALF + m] = ss;
            }
        __syncthreads();
        if (tid < 256) {
            const float s = (xl[tid] + xl[256 + tid]) + (xl[512 + tid] + xl[768 + tid]);
            __hip_atomic_store(ssp + (size_t)(u.pm * BM + tid) * 8 + u.pn, s, __ATOMIC_RELAXED, __HIP_MEMORY_SCOPE_AGENT);
        }
        asm volatile("s_waitcnt vmcnt(0)" ::: "memory");
        __syncthreads();
        if (tid == 0) {
            __hip_atomic_fetch_add(cnt + u.pm, 1u, __ATOMIC_RELAXED, __HIP_MEMORY_SCOPE_AGENT);
            while (__hip_atomic_load(cnt + u.pm, __ATOMIC_RELAXED, __HIP_MEMORY_SCOPE_AGENT) < 8u) __builtin_amdgcn_s_sleep(4);
        }
        __syncthreads();
        if (tid < 256) {
            const float* sp = ssp + (size_t)(u.pm * BM + tid) * 8;
            float s = 0.f;
#pragma unroll
            for (int k = 0; k < 8; ++k) s += __hip_atomic_load(sp + k, __ATOMIC_RELAXED, __HIP_MEMORY_SCOPE_AGENT);
            xl[1024 + tid] = rsqrtf(s * (1.f / DM) + EPS);
        }
        __syncthreads();
        f32x4 g[2][2];
#pragma unroll
        for (int bj = 0; bj < 2; ++bj)
#pragma unroll
            for (int n = 0; n < 2; ++n) g[bj][n] = *(const f32x4*)(fg + colt + bj * HALF + 4 * n);
#pragma unroll
        for (int ai = 0; ai < 2; ++ai)
#pragma unroll
            for (int m = 0; m < 4; ++m) {
                const float rstd = xl[1024 + rl + ai * HALF + m];
#pragma unroll
                for (int bj = 0; bj < 2; ++bj)
#pragma unroll
                    for (int n = 0; n < 2; ++n)
                        *(f32x4*)(out + (size_t)(rowt + ai * HALF + m) * DM + colt + bj * HALF + 4 * n) = acc[ai][bj][m][n] * rstd * g[bj][n];
            }
    }
};

DI void sb_unit(const Params& p, int wu, int lane, LAS unsigned char* wl, const LAS float* sbgl) {
    unsigned char* ws = p.ws;
    const int bh = wu >> 7, tb = wu & 127, t0 = tb * 32, r = lane & 31, hh = lane >> 5, h = bh & 7, b = bh >> 3;
    const int pr = 16 * ((r >> 2) & 1) + 4 * (r >> 3) + (r & 3);
    const bf16_t* qp = (const bf16_t*)(ws + WS_SQ) + ((size_t)bh * SEQ + t0 + r) * HD + hh * 8;
    const int krow = lane >> 4, kpos = lane & 15;
    const int vrow = lane >> 2, vpos = lane & 3;
    const char* ksrc = (const char*)((const bf16_t*)(ws + WS_SK) + (size_t)bh * SEQ * HD);
    const char* vsrc = (const char*)((const bf16_t*)(ws + WS_SVT) + (size_t)bh * 32 * HD * 128);
    LAS unsigned char* Kw = wl; LAS unsigned char* Vw = wl + 8192;
    int koff[8], voff[4][2];
    {
        const int f = (pr & 7) + 8 * (pr >> 4);
#pragma unroll
        for (int ks = 0; ks < 8; ++ks) koff[ks] = pr * 256 + (((2 * ks + hh) ^ f) * 16);
#pragma unroll
        for (int et = 0; et < 4; ++et)
#pragma unroll
            for (int s2 = 0; s2 < 2; ++s2) { const int row = et * 32 + r; voff[et][s2] = row * 64 + (((2 * hh + s2) ^ ((row >> 2) & 3)) * 16); }
    }
    const int kcb16 = (kpos ^ krow) * 16;
    const int vc16 = (vpos ^ ((vrow >> 2) & 3)) * 16;
    const int kx0 = krow * 256 + (kcb16 ^ 0), kx1 = krow * 256 + (kcb16 ^ 64), kx2 = krow * 256 + (kcb16 ^ 128) + 4096, kx3 = krow * 256 + (kcb16 ^ 192) + 4096;
    const int vx0 = vrow * 64 + vc16;
#define SB_DMA(P, L, OFF) __builtin_amdgcn_global_load_lds((const unsigned*)(P), (LAS unsigned*)(L), 16, OFF, 0)
#define SB_ISSUE_K(S0) do { const char* _b = ksrc + (size_t)(S0) * 256; \
        const char* _p0 = _b + kx0; const char* _p1 = _b + kx1; const char* _p2 = _b + kx2; const char* _p3 = _b + kx3; \
        SB_DMA(_p0, Kw, 0); SB_DMA(_p1, Kw, 1024); SB_DMA(_p0, Kw, 2048); SB_DMA(_p1, Kw, 3072); \
        SB_DMA(_p2, Kw + 4096, 0); SB_DMA(_p3, Kw + 4096, 1024); SB_DMA(_p2, Kw + 4096, 2048); SB_DMA(_p3, Kw + 4096, 3072); } while (0)
#define SB_ISSUE_V(S0) do { const char* _p = vsrc + (size_t)((S0) >> 5) * 8192 + vx0; const char* _q = _p + 4096; \
        SB_DMA(_p, Vw, 0); SB_DMA(_p, Vw, 1024); SB_DMA(_p, Vw, 2048); SB_DMA(_p, Vw, 3072); \
        SB_DMA(_q, Vw + 4096, 0); SB_DMA(_q, Vw + 4096, 1024); SB_DMA(_q, Vw + 4096, 2048); SB_DMA(_q, Vw + 4096, 3072); } while (0)
    asm volatile("s_waitcnt vmcnt(0)" ::: "memory");
    SB_ISSUE_K(t0); SB_ISSUE_V(t0);
    bf16x8 qf[8];
#pragma unroll
    for (int ks = 0; ks < 8; ++ks) qf[ks] = *(const bf16x8*)(qp + ks * 16);
    f32x16 o[4];
#pragma unroll
    for (int et = 0; et < 4; ++et)
#pragma unroll
        for (int i = 0; i < 16; ++i) o[et][i] = 0.f;
    float carry = 1.f;
    asm volatile("s_waitcnt vmcnt(0)" ::: "memory");
    for (int s0 = t0; s0 >= 0; s0 -= 32) {
        const bool more = (s0 >= 32);
        f32x16 st;
        {
            bf16x8 kf[8];
            asm volatile("s_waitcnt vmcnt(8)" ::: "memory");
#pragma unroll
            for (int ks = 0; ks < 8; ++ks) kf[ks] = *(const LAS bf16x8*)(Kw + koff[ks]);
            asm volatile("s_waitcnt lgkmcnt(0)" ::: "memory");
            if (more) SB_ISSUE_K(s0 - 32);
#pragma unroll
            for (int i = 0; i < 16; ++i) st[i] = 0.f;
            __builtin_amdgcn_s_setprio(1);
#pragma unroll
            for (int ks = 0; ks < 8; ++ks) st = MFMA32(kf[ks], qf[ks], st);
            __builtin_amdgcn_s_setprio(0);
        }
        const bool diag = (s0 == t0);
        const int kbase_i = 16 * hh;
        float exs[16], bt[16];
        float run = 1.f;
#pragma unroll
        for (int i = 15; i >= 0; --i) {
            const float z = __builtin_amdgcn_fmed3f(st[i], -60.f, 60.f);
            const float en = ex2(-z);
            float bta = __builtin_amdgcn_rcpf(1.f + en);
            float kp = en * bta;
            if (diag) { const bool ok = (kbase_i + i < r); bta = ok ? bta : 0.f; kp = ok ? kp : 1.f; }
            exs[i] = run; bt[i] = bta;
            run *= kp;
        }
        const float T = run;
        const float U = __shfl_xor(T, 32);
        const float off = carry * (hh == 0 ? U : 1.f);
        float a[16];
#pragma unroll
        for (int i = 0; i < 16; ++i) a[i] = bt[i] * (off * exs[i]);
        carry *= T * U;
        {
            bf16x8 vf[4][2];
            if (more) asm volatile("s_waitcnt vmcnt(8)" ::: "memory"); else asm volatile("s_waitcnt vmcnt(0)" ::: "memory");
#pragma unroll
            for (int et = 0; et < 4; ++et)
#pragma unroll
                for (int s2 = 0; s2 < 2; ++s2) vf[et][s2] = *(const LAS bf16x8*)(Vw + voff[et][s2]);
            asm volatile("s_waitcnt lgkmcnt(0)" ::: "memory");
            if (more) SB_ISSUE_V(s0 - 32);
            __builtin_amdgcn_s_setprio(1);
#pragma unroll
            for (int s2 = 0; s2 < 2; ++s2) {
                u32x4 pw; pw.x = pk2(a[8 * s2], a[8 * s2 + 1]); pw.y = pk2(a[8 * s2 + 2], a[8 * s2 + 3]); pw.z = pk2(a[8 * s2 + 4], a[8 * s2 + 5]); pw.w = pk2(a[8 * s2 + 6], a[8 * s2 + 7]);
                const bf16x8 pf = __builtin_bit_cast(bf16x8, pw);
#pragma unroll
                for (int et = 0; et < 4; ++et) o[et] = MFMA32(vf[et][s2], pf, o[et]);
            }
            __builtin_amdgcn_s_setprio(0);
        }
        if (__all(carry < 1.17549435e-38f)) break;
    }
#undef SB_ISSUE_K
#undef SB_ISSUE_V
#undef SB_DMA

    float ss = 0.f;
#pragma unroll
    for (int et = 0; et < 4; ++et)
#pragma unroll
        for (int i = 0; i < 16; ++i) ss += o[et][i] * o[et][i];
    ss += __shfl_xor(ss, 32);
    const float rstd = rsqrtf(ss * (1.f / HD) + EPS);
    const int t = t0 + r;
    const bf16_t* gp = (const bf16_t*)(ws + WS_SG) + ((size_t)bh * SEQ + t) * HD;
    bf16_t* mp = (bf16_t*)(ws + WS_MIX) + ((size_t)(b * SEQ + t)) * DM + 1024 + h * HD;
    u32x2 gw[4][4];
#pragma unroll
    for (int et = 0; et < 4; ++et)
#pragma unroll
        for (int q = 0; q < 4; ++q) gw[et][q] = *(const u32x2*)(gp + et * 32 + 8 * q + 4 * hh);
    u32x2 wv[16];
#pragma unroll
    for (int et = 0; et < 4; ++et)
#pragma unroll
        for (int q = 0; q < 4; ++q) {
            const int e = et * 32 + 8 * q + 4 * hh;
            const f32x4 gn = *(const LAS f32x4*)(sbgl + h * HD + e);
            const float g0 = __uint_as_float(gw[et][q].x << 16), g1 = __uint_as_float(gw[et][q].x & 0xffff0000u), g2 = __uint_as_float(gw[et][q].y << 16), g3 = __uint_as_float(gw[et][q].y & 0xffff0000u);
            u32x2 w;
            w.x = pk2(o[et][4 * q] * rstd * gn[0] * g0, o[et][4 * q + 1] * rstd * gn[1] * g1);
            w.y = pk2(o[et][4 * q + 2] * rstd * gn[2] * g2, o[et][4 * q + 3] * rstd * gn[3] * g3);
            wv[et * 4 + q] = w;
        }
#pragma unroll
    for (int k = 0; k < 16; k += 2) {
        const auto rx = __builtin_amdgcn_permlane32_swap(wv[k].x, wv[k + 1].x, false, false);
        const auto ry = __builtin_amdgcn_permlane32_swap(wv[k].y, wv[k + 1].y, false, false);
        u32x4 st4; st4.x = rx[0]; st4.y = ry[0]; st4.z = rx[1]; st4.w = ry[1];
        *(u32x4*)(mp + 8 * k + 8 * hh) = st4;
    }
}

DI void blk_load4(u32x4 (&r)[4], const bf16_t* g, int tid) {
#pragma unroll
    for (int i = 0; i < 4; ++i) r[i] = __builtin_nontemporal_load((const u32x4*)(g + (size_t)(tid + 512 * i) * 8));
}
DI void blk_store4(LAS unsigned char* l, const u32x4 (&r)[4], int tid) {
#pragma unroll
    for (int i = 0; i < 4; ++i) { const int ch = tid + 512 * i; *(LAS u32x4*)(l + (ch >> 4) * 272 + (ch & 15) * 16) = r[i]; }
}
constexpr int TB = 128 * 272;

DI void state2(const Params& p, int w, int lane) {
    unsigned char* ws = p.ws;
    const int fr = lane & 15, fq = lane >> 4;
    for (int u0 = blockIdx.x; u0 < 256; u0 += gridDim.x) {
        const int unit = (u0 & 7) * 32 + (u0 >> 3);
        const int bh = unit >> 2, eh = unit & 1, dh = (unit >> 1) & 1, h = bh & 7;
        const float gc = ex2(l2gamma(h) * 128.f);
        const int d0 = dh * 64, e0 = eh * 64 + w * 32;
        const bf16_t* kt = (const bf16_t*)(ws + WS_KTZ) + ((size_t)bh * 32 * HD + d0 + fr) * 128 + fq * 8;
        const bf16_t* vt = (const bf16_t*)(ws + WS_RVT) + ((size_t)bh * 32 * HD + e0 + fr) * 128 + fq * 8;
        bf16_t* rp = (bf16_t*)(ws + WS_RP) + ((size_t)bh * 32 * HD + e0 + fr) * 128 + d0 + 4 * fq;
        f32x4 R[2][4];
#pragma unroll
        for (int et = 0; et < 2; ++et)
#pragma unroll
            for (int dl = 0; dl < 4; ++dl) R[et][dl] = (f32x4){0.f, 0.f, 0.f, 0.f};
        bf16x8 kf[4][4], vf[2][4];
#define ST_LOAD(C) do { _Pragma("unroll") for (int ks = 0; ks < 4; ++ks) { \
            _Pragma("unroll") for (int dl = 0; dl < 4; ++dl) kf[dl][ks] = *(const bf16x8*)(kt + (size_t)(C) * 16384 + dl * 16 * 128 + ks * 32); \
            _Pragma("unroll") for (int et = 0; et < 2; ++et) vf[et][ks] = *(const bf16x8*)(vt + (size_t)(C) * 16384 + et * 16 * 128 + ks * 32); } } while (0)
        ST_LOAD(0);
#pragma unroll 1
        for (int c = 0; c < 32; ++c) {
            const int cn = (c + 1 < 32) ? c + 1 : 31;
            __builtin_amdgcn_sched_barrier(0);
#pragma unroll
            for (int et = 0; et < 2; ++et)
#pragma unroll
                for (int dl = 0; dl < 4; ++dl) {
                    u32x2 w2; w2.x = pk2(R[et][dl][0], R[et][dl][1]); w2.y = pk2(R[et][dl][2], R[et][dl][3]);
                    *(u32x2*)(rp + (size_t)c * 16384 + et * 16 * 128 + dl * 16) = w2;
                    f32x4 a = {0.f, 0.f, 0.f, 0.f};
#pragma unroll
                    for (int ks = 0; ks < 4; ++ks) a = MFMA16(kf[dl][ks], vf[et][ks], a);
                    R[et][dl] = R[et][dl] * gc + a;
                }
            __builtin_amdgcn_sched_barrier(0);
            ST_LOAD(cn);
            __builtin_amdgcn_sched_barrier(0);
        }
#undef ST_LOAD
    }
}

DI void phase_mix1(const Params& p, LAS unsigned char* lds) {
    const int wid = __builtin_amdgcn_readfirstlane(threadIdx.x >> 6), lane = threadIdx.x & 63;
    LAS unsigned* qctr = (LAS unsigned*)(lds + 131072 + 6144);
    if (threadIdx.x == 0) *qctr = 0u;
    LAS float* sbgl = (LAS float*)(lds + 131072);
    if (threadIdx.x < 256) *(LAS f32x4*)(sbgl + threadIdx.x * 4) = *(const f32x4*)(p.sbg + threadIdx.x * 4);
    __syncthreads();
    if (wid < 2) state2(p, wid, lane);
    const int per = (8192 + (int)gridDim.x - 1) / (int)gridDim.x;
    const int base = blockIdx.x * per, end = (base + per < 8192) ? base + per : 8192;
    for (;;) {
        unsigned k = 0;
        if (lane == 0) k = __hip_atomic_fetch_add(qctr, 1u, __ATOMIC_RELAXED, __HIP_MEMORY_SCOPE_WORKGROUP);
        k = __builtin_amdgcn_readfirstlane(k);
        if (base + (int)k >= end) break;
        sb_unit(p, base + (int)k, lane, lds + wid * 16384, sbgl);
    }
    asm volatile("s_waitcnt vmcnt(0)" ::: "memory");
}

DI void phase_mix2(const Params& p, LAS unsigned char* lds) {
    unsigned char* ws = p.ws;
    const int tid = threadIdx.x, w = __builtin_amdgcn_readfirstlane(tid >> 6), lane = tid & 63, fr = lane & 15, fq = lane >> 4, n0 = 16 * w;
    LAS unsigned char* Ks = lds; LAS unsigned char* Vs = lds + TB; LAS unsigned char* Rs = lds + 2 * TB;
    const bf16_t* gK = (const bf16_t*)(ws + WS_RK); const bf16_t* gV = (const bf16_t*)(ws + WS_RVT); const bf16_t* gR = (const bf16_t*)(ws + WS_RP);
    const bf16_t* gQ = (const bf16_t*)(ws + WS_RQ) + (size_t)(n0 + fr) * HD + fq * 8;
    LAS float* Gs = (LAS float*)(lds + 3 * TB);
    { const f32x4 a = *(const f32x4*)(p.gng + (tid & 255) * 4), bq = *(const f32x4*)(p.gnb + (tid & 255) * 4); if (tid < 256) *(LAS f32x4*)(Gs + tid * 4) = a; else *(LAS f32x4*)(Gs + 1024 + (tid - 256) * 4) = bq; }
    u32x4 rk[4], rv[4], rr[4]; bf16x8 qn[4];
    int u = blockIdx.x;
    if (u < 2048) {
        blk_load4(rk, gK + (size_t)u * 16384, tid); blk_load4(rv, gV + (size_t)u * 16384, tid); blk_load4(rr, gR + (size_t)u * 16384, tid);
#pragma unroll
        for (int ks = 0; ks < 4; ++ks) qn[ks] = *(const bf16x8*)(gQ + (size_t)u * 16384 + ks * 32);
    }
    for (; u < 2048; u += gridDim.x) {
        const int bh = u >> 5, c = u & 31, h = bh & 7, b = bh >> 3;
        blk_store4(Ks, rk, tid); blk_store4(Vs, rv, tid); blk_store4(Rs, rr, tid);
        bf16x8 qf[4];
#pragma unroll
        for (int ks = 0; ks < 4; ++ks) qf[ks] = qn[ks];
        __syncthreads();
        const int un = u + gridDim.x;
        if (un < 2048) {
            blk_load4(rk, gK + (size_t)un * 16384, tid); blk_load4(rv, gV + (size_t)un * 16384, tid); blk_load4(rr, gR + (size_t)un * 16384, tid);
#pragma unroll
            for (int ks = 0; ks < 4; ++ks) qn[ks] = *(const bf16x8*)(gQ + (size_t)un * 16384 + ks * 32);
        }
        const int s = c * 128 + n0 + fr;
        const bf16_t* gp = (const bf16_t*)(ws + WS_RG) + ((size_t)bh * SEQ + s) * HD + fq * 4;
        __builtin_amdgcn_sched_barrier(0);
        const float l2g = l2gamma(h);
        f32x4 ot[8];
        float basef = (float)(n0 + fr - 8 * fq);
        asm volatile("" : "+v"(basef));
        const float lb = l2g * basef;
        const float xi = ex2(l2g * (float)(n0 + fr + 1));
#pragma unroll
        for (int et = 0; et < 8; ++et) {
            ot[et] = (f32x4){0.f, 0.f, 0.f, 0.f};
#pragma unroll
            for (int ks = 0; ks < 4; ++ks) { const bf16x8 rf = *(const LAS bf16x8*)(Rs + (et * 16 + fr) * 272 + ks * 64 + fq * 16); ot[et] = MFMA16(rf, qf[ks], ot[et]); }
            ot[et] *= xi;
        }
        __builtin_amdgcn_sched_barrier(0);
        u32x2 gw[8];
#pragma unroll
        for (int et = 0; et < 8; ++et) gw[et] = *(const u32x2*)(gp + et * 16);
        __builtin_amdgcn_sched_barrier(0);
#pragma unroll
        for (int kk = 0; kk < 4; ++kk) {
            if (2 * kk <= w) {
                f32x4 st[2];
#pragma unroll
                for (int tt = 0; tt < 2; ++tt) {
                    st[tt] = (f32x4){0.f, 0.f, 0.f, 0.f};
#pragma unroll
                    for (int ks = 0; ks < 4; ++ks) { const bf16x8 kf = *(const LAS bf16x8*)(Ks + (32 * kk + 4 * tt + 8 * (fr >> 2) + (fr & 3)) * 272 + ks * 64 + fq * 16); st[tt] = MFMA16(kf, qf[ks], st[tt]); }
#pragma unroll
                    for (int j = 0; j < 4; ++j) {
                        const float cj = (float)(32 * kk + 4 * tt + j);
                        st[tt][j] = (basef >= cj) ? st[tt][j] * ex2(lb - l2g * cj) : 0.f;
                    }
                }
                u32x4 pw; pw.x = pk2(st[0][0], st[0][1]); pw.y = pk2(st[0][2], st[0][3]); pw.z = pk2(st[1][0], st[1][1]); pw.w = pk2(st[1][2], st[1][3]);
                const bf16x8 pf = __builtin_bit_cast(bf16x8, pw);
#pragma unroll
                for (int et = 0; et < 8; ++et) { const bf16x8 vf = *(const LAS bf16x8*)(Vs + (et * 16 + fr) * 272 + (32 * kk + 8 * fq) * 2); ot[et] = MFMA16(vf, pf, ot[et]); }
            }
        }
        float sum = 0.f;
#pragma unroll
        for (int et = 0; et < 8; ++et)
#pragma unroll
            for (int j = 0; j < 4; ++j) sum += ot[et][j];
        sum += __shfl_xor(sum, 16); sum += __shfl_xor(sum, 32);
        const float mean = sum * (1.f / HD);
        float sq = 0.f;
#pragma unroll
        for (int et = 0; et < 8; ++et)
#pragma unroll
            for (int j = 0; j < 4; ++j) { const float d = ot[et][j] - mean; sq += d * d; }
        sq += __shfl_xor(sq, 16); sq += __shfl_xor(sq, 32);
        const float rstd = rsqrtf(sq * (1.f / HD) + EPS);
        bf16_t* mp = (bf16_t*)(ws + WS_MIX) + ((size_t)(b * SEQ + s)) * DM + h * HD;
#pragma unroll
        for (int ep = 0; ep < 8; ep += 2) {
            u32x2 wv[2];
#pragma unroll
            for (int t2 = 0; t2 < 2; ++t2) {
                const int et = ep + t2;
                const f32x4 gn = *(const LAS f32x4*)(Gs + h * HD + et * 16 + fq * 4), gb = *(const LAS f32x4*)(Gs + 1024 + h * HD + et * 16 + fq * 4);
                const float g0 = __uint_as_float(gw[et].x << 16), g1 = __uint_as_float(gw[et].x & 0xffff0000u), g2 = __uint_as_float(gw[et].y << 16), g3 = __uint_as_float(gw[et].y & 0xffff0000u);
                wv[t2].x = pk2(((ot[et][0] - mean) * rstd * gn[0] + gb[0]) * g0, ((ot[et][1] - mean) * rstd * gn[1] + gb[1]) * g1);
                wv[t2].y = pk2(((ot[et][2] - mean) * rstd * gn[2] + gb[2]) * g2, ((ot[et][3] - mean) * rstd * gn[3] + gb[3]) * g3);
            }
            const auto rx = __builtin_amdgcn_permlane16_swap(wv[0].x, wv[1].x, false, false);
            const auto ry = __builtin_amdgcn_permlane16_swap(wv[0].y, wv[1].y, false, false);
            u32x4 st4; st4.x = rx[0]; st4.y = ry[0]; st4.z = rx[1]; st4.w = ry[1];
            *(u32x4*)(mp + 16 * (ep + (fq & 1)) + 8 * (fq >> 1)) = st4;
        }
        __syncthreads();
    }
}

DI void phase_final(const Params& p) {
    const int wid = threadIdx.x >> 6, lane = threadIdx.x & 63;
    const float* ssp = (const float*)(p.ws + WS_SSP);
    f32x4 g[8];
#pragma unroll
    for (int i = 0; i < 8; ++i) g[i] = ((const f32x4*)p.fg)[lane + 64 * i];
    for (int row = blockIdx.x * 8 + wid; row < NTOK; row += gridDim.x * 8) {
        float ss = (lane < 32) ? ssp[(size_t)row * 32 + lane] : 0.f;
        f32x4* yr = (f32x4*)(p.out + (size_t)row * DM);
        f32x4 v[8];
#pragma unroll
        for (int i = 0; i < 8; ++i) v[i] = yr[lane + 64 * i];
        ss = wave_sum(ss);
        const float rstd = rsqrtf(ss * (1.f / DM) + EPS);
#pragma unroll
        for (int i = 0; i < 8; ++i) yr[lane + 64 * i] = v[i] * rstd * g[i];
    }
}

#ifndef PHM
#define PHM 127
#endif
__global__ void __launch_bounds__(512, 2) mega(Params p) {
    extern __shared__ __attribute__((aligned(16))) unsigned char shm[];
    LAS unsigned char* lds = (LAS unsigned char*)shm;
    cg::grid_group grid = cg::this_grid();
    volatile LAS unsigned* xst = (volatile LAS unsigned*)(lds + 131072 + 6400);
    if (threadIdx.x == 0) { xst[0] = 0u; xst[1] = 0u; }
    __syncthreads();
    const XcdBarrier xb = xcd_barrier_post((unsigned*)(p.ws + WS_BAR), xst);
    const bool coop = (p.ph_lo == 0 && p.ph_hi == 7);
#define RUNS(k) (p.ph_lo <= (k) && (k) < p.ph_hi)
#define SYNC_AFTER(k) do { if (RUNS(k) && (k) + 1 < p.ph_hi) { if (coop) xcd_barrier(xb); else grid.sync(); } } while (0)
    if (RUNS(0)) { if (PHM & 1) phase_prep(p, lds); }
    SYNC_AFTER(0);
    if (RUNS(1)) { if (PHM & 2) { Epi1 e; e.ws = p.ws; gemm_phase(lds, (const bf16_t*)(p.ws + WS_HB), (const bf16_t*)(p.ws + WS_WTIN), NTOK, INC, DM, e, 0); } }
    SYNC_AFTER(1);
    if (RUNS(2)) { if (PHM & 4) phase_mix1(p, lds); }
    SYNC_AFTER(2);
    if (RUNS(4)) { if (PHM & 16) phase_mix2(p, lds); }
    SYNC_AFTER(4);
    const bool fuse_norm = (gridDim.x == 256);
    if (RUNS(5)) { if (PHM & 32) {
        if (fuse_norm) { Epi2F e; e.x = p.x; e.out = p.out; e.ssp = (float*)(p.ws + WS_SSP); e.cnt = (unsigned*)(p.ws + WS_CNT); e.fg = p.fg; e.xl = (LAS float*)(lds + 131072); gemm_phase(lds, (const bf16_t*)(p.ws + WS_MIX), (const bf16_t*)(p.ws + WS_WTOUT), NTOK, DM, DM, e, 1); }
        else { Epi2 e; e.x = p.x; e.out = p.out; e.ssp = (float*)(p.ws + WS_SSP); gemm_phase(lds, (const bf16_t*)(p.ws + WS_MIX), (const bf16_t*)(p.ws + WS_WTOUT), NTOK, DM, DM, e, 0); } } }
    if (!fuse_norm) {
    SYNC_AFTER(5);
    if (RUNS(6)) { if (PHM & 64) phase_final(p); }
    }
}

constexpr int LDS_BYTES = 131072 + 8192;
#ifndef N_LAUNCH_MODE
#define N_LAUNCH_MODE 1
#endif

extern "C" void kernel_launch(void* const* d_in, const int* in_sizes, int n_in, void* d_out, int out_size, void* d_ws, size_t ws_size, hipStream_t stream) {
    static int grid = 0;
    if (grid == 0) {
        if (ws_size < WS_END) { fprintf(stderr, "kernel_launch: workspace too small (%zu < %zu)\n", ws_size, (size_t)WS_END); grid = -1; return; }
        int dev = 0, cus = 0, per_cu = 0;
        hipGetDevice(&dev);
        hipDeviceGetAttribute(&cus, hipDeviceAttributeMultiprocessorCount, dev);
        if (hipFuncSetAttribute((const void*)mega, hipFuncAttributeMaxDynamicSharedMemorySize, LDS_BYTES) != hipSuccess) { fprintf(stderr, "kernel_launch: hipFuncSetAttribute failed\n"); grid = -1; return; }
        if (hipOccupancyMaxActiveBlocksPerMultiprocessor(&per_cu, (const void*)mega, 512, LDS_BYTES) != hipSuccess || per_cu < 1) per_cu = 1;
        (void)hipGetLastError();
        grid = cus * 1;
        if (grid <= 0) grid = 256;
    }
    if (grid < 0) return;
    Params p{};
    p.x = (const float*)d_in[0]; p.ng = (const float*)d_in[1]; p.w_in = (const float*)d_in[2]; p.gng = (const float*)d_in[3]; p.gnb = (const float*)d_in[4];
    p.sbg = (const float*)d_in[5]; p.w_out = (const float*)d_in[6]; p.fg = (const float*)d_in[7];
    p.out = (float*)d_out; p.ws = (unsigned char*)d_ws;
#if N_LAUNCH_MODE == 1
    (void)hipMemsetAsync((char*)d_ws + WS_BAR, 0, 16384, stream);
    p.ph_lo = 0; p.ph_hi = 7;
    void* args[] = {&p};
    hipError_t e = hipLaunchCooperativeKernel((const void*)mega, dim3(grid), dim3(512), args, LDS_BYTES, stream);
    if (e != hipSuccess) fprintf(stderr, "cooperative launch failed: %s (grid %d)\n", hipGetErrorString(e), grid);
#else
    for (int ph = 0; ph < 7; ++ph) {
        p.ph_lo = ph; p.ph_hi = ph + 1;
        hipLaunchKernelGGL(mega, dim3(grid), dim3(512), LDS_BYTES, stream, p);
    }
#endif
}
```

```cpp
#include <hip/hip_runtime.h>
#include <hip/hip_cooperative_groups.h>
#include <cstdio>
namespace cg = cooperative_groups;

#define LAS __attribute__((address_space(3)))
#define DI __device__ __forceinline__
typedef unsigned short bf16_t;
typedef short bf16x8 __attribute__((ext_vector_type(8)));
typedef short s16x4 __attribute__((ext_vector_type(4)));
typedef float f32x2 __attribute__((ext_vector_type(2)));
typedef float f32x4 __attribute__((ext_vector_type(4)));
typedef float f32x16 __attribute__((ext_vector_type(16)));
typedef unsigned u32x2 __attribute__((ext_vector_type(2)));
typedef unsigned u32x4 __attribute__((ext_vector_type(4)));
typedef __bf16 bf16v2 __attribute__((ext_vector_type(2)));

constexpr int SEQ = 4096, DM = 2048, NTOK = 32768, INC = 8192, HD = 128;
constexpr float EPS = 1e-6f;
constexpr float LOG2E = 1.4426950408889634f;
constexpr float KSCALE = 0.08838834764831845f;

constexpr size_t SZ64 = 67108864ull;
constexpr size_t WS_HB = 0;
constexpr size_t WS_MIX = 0;
constexpr size_t WS_WTIN = 134217728ull;
constexpr size_t WS_WTOUT = WS_WTIN + 33554432ull;
constexpr size_t WS_RQ = WS_WTOUT + 8388608ull;
constexpr size_t WS_RK = WS_RQ + SZ64;
constexpr size_t WS_KTZ = WS_RK + SZ64;
constexpr size_t WS_RVT = WS_KTZ + SZ64;
constexpr size_t WS_RG = WS_RVT + SZ64;
constexpr size_t WS_SQ = WS_RG + SZ64;
constexpr size_t WS_SK = WS_SQ + SZ64;
constexpr size_t WS_SVT = WS_SK + SZ64;
constexpr size_t WS_SG = WS_SVT + SZ64;
constexpr size_t WS_KV = WS_SG + SZ64;
constexpr size_t WS_RP = WS_KV + 134217728ull;
constexpr size_t WS_ROPE = WS_RP + SZ64;
constexpr size_t WS_SSP = WS_ROPE + 2097152ull;
constexpr size_t WS_CNT = WS_SSP + 4194304ull;
constexpr size_t WS_BAR = WS_CNT + 4096ull;
constexpr size_t WS_END = WS_BAR + 16384ull;

struct Params {
    const float* x; const float* ng; const float* w_in; const float* gng; const float* gnb; const float* sbg; const float* w_out; const float* fg;
    float* out; unsigned char* ws; int ph_lo; int ph_hi;
};

DI unsigned pk2(float lo, float hi) { f32x2 v = {lo, hi}; bf16v2 r = __builtin_convertvector(v, bf16v2); return __builtin_bit_cast(unsigned, r); }
DI bf16_t bf1(float x) { return (bf16_t)(pk2(x, x) & 0xffffu); }
DI float ex2(float x) { return __builtin_amdgcn_exp2f(x); }
DI float lg2(float x) { return __builtin_amdgcn_logf(x); }
DI float l2gamma(int h) {
    const float x = __uint_as_float((unsigned)(127 - 5 - h) << 23);
    const float s = x * (1.f + x * (0.5f + x * (0.33333334f + x * (0.25f + x * (0.2f + x * 0.16666667f)))));
    return -s * LOG2E;
}
DI float silu(float v) { return v * __builtin_amdgcn_rcpf(1.f + ex2(-v * LOG2E)); }
DI float wave_sum(float v) {
#pragma unroll
    for (int o = 32; o >= 1; o >>= 1) v += __shfl_xor(v, o);
    return v;
}
#define MFMA16(a, b, c) __builtin_amdgcn_mfma_f32_16x16x32_bf16((a), (b), (c), 0, 0, 0)
#define MFMA32(a, b, c) __builtin_amdgcn_mfma_f32_32x32x16_bf16((a), (b), (c), 0, 0, 0)

DI int dst_row_in(int nsrc) {
    const int pn = nsrc >> 8, off = nsrc & 255, grp = pn >> 2, bj = off >> 7, cc = off & 127;
    int rho;
    if (grp < 2) { const int n = cc >> 6, a = cc & 63; rho = 32 * (a >> 4) + 16 * n + (a & 15); }
    else { const int wc = cc >> 5, fq = (cc >> 3) & 3, n = (cc >> 2) & 1, j = cc & 3; rho = 32 * wc + 16 * n + 4 * fq + j; }
    return pn * 256 + bj * 128 + rho;
}
DI int dst_row_out(int nsrc) {
    const int pn = nsrc >> 8, off = nsrc & 255, bj = off >> 7, cc = off & 127;
    const int wc = cc >> 5, fq = (cc >> 3) & 3, n = (cc >> 2) & 1, j = cc & 3;
    return pn * 256 + bj * 128 + 32 * wc + 16 * n + 4 * fq + j;
}


#define XB_TMO      128
#define XB_XCNT(j)  (256  + 64 * (j))
#define XB_XSUB(j)  (1280 + 64 * (j))
#define XB_XGEN(j)  (2304 + 64 * (j))
#define XB_TOP      3328
#define XB_TOPGEN   3392
#define XCD_BAR_WORDS 3456
#define XB_SPIN_CAP (1u << 22)
DI unsigned xb_ld(unsigned* p)              { return __hip_atomic_load(p, __ATOMIC_RELAXED, __HIP_MEMORY_SCOPE_AGENT); }
DI unsigned xb_add(unsigned* p, unsigned v) { return __hip_atomic_fetch_add(p, v, __ATOMIC_RELAXED, __HIP_MEMORY_SCOPE_AGENT); }
DI unsigned xb_xcc_id() { return (unsigned)__builtin_amdgcn_s_getreg((3 << 11) | 20) & 0xFu; }
#define XB_SPIN(cond, bar) do { unsigned _sp = 0; while (cond) { __builtin_amdgcn_s_sleep(1); \
    if ((++_sp & 255u) == 0u) { if (xb_ld(&(bar)[XB_TMO])) break; if (_sp > XB_SPIN_CAP) { atomicAdd(&(bar)[XB_TMO], 1u); break; } } } } while (0)
struct XcdBarrier { unsigned* bar; unsigned x; volatile LAS unsigned* st; };
DI XcdBarrier xcd_barrier_post(unsigned* bar, volatile LAS unsigned* st) {
    XcdBarrier b; b.bar = bar; b.x = xb_xcc_id(); b.st = st;
    if (threadIdx.x == 0) (void)xb_add(&bar[XB_XCNT(b.x)], 1u);
    return b;
}
DI void xcd_barrier_complete(unsigned* bar, unsigned x, unsigned& nloc, unsigned& nx) {
    const unsigned G = gridDim.x * gridDim.y * gridDim.z;
    unsigned sum, cnt, mine, sp = 0u;
    for (;;) {
        sum = 0u; cnt = 0u; mine = 0u;
#pragma unroll
        for (unsigned j = 0; j < 16; ++j) { const unsigned c = xb_ld(&bar[XB_XCNT(j)]); sum += c; cnt += (c > 0u) ? 1u : 0u; mine = (j == x) ? c : mine; }
        if (sum == G) break;
        __builtin_amdgcn_s_sleep(1);
        if ((++sp & 255u) == 0u) { if (xb_ld(&bar[XB_TMO])) break; if (sp > XB_SPIN_CAP) { atomicAdd(&bar[XB_TMO], 1u); break; } }
    }
    nloc = mine > 0u ? mine : 1u; nx = cnt > 0u ? cnt : 1u;
}
DI void xcd_barrier(const XcdBarrier& b) {
    asm volatile("s_waitcnt vmcnt(0)" ::: "memory");
    __syncthreads();
    if (threadIdx.x == 0) {
        unsigned* bar = b.bar;
        __builtin_amdgcn_s_waitcnt(0);
        unsigned nloc = b.st[0], nx = b.st[1];
        if (nloc == 0u) { xcd_barrier_complete(bar, b.x, nloc, nx); b.st[0] = nloc; b.st[1] = nx; }
        const unsigned old = xb_add(&bar[XB_XSUB(b.x)], 1u);
        const unsigned gen = old / nloc;
        if (old + 1u == (gen + 1u) * nloc) {
            __builtin_amdgcn_fence(__ATOMIC_RELEASE, "agent");
            asm volatile("s_waitcnt vmcnt(0)" ::: "memory");
            const unsigned og = xb_add(&bar[XB_TOP], 1u);
            const unsigned tg = og / nx;
            if (og + 1u == (tg + 1u) * nx) xb_add(&bar[XB_TOPGEN], 1u);
            else XB_SPIN(xb_ld(&bar[XB_TOPGEN]) == tg, bar);
            __builtin_amdgcn_fence(__ATOMIC_ACQUIRE, "agent");
            xb_add(&bar[XB_XGEN(b.x)], 1u);
            asm volatile("s_waitcnt vmcnt(0)" ::: "memory");
        } else {
            XB_SPIN(xb_ld(&bar[XB_XGEN(b.x)]) == gen, bar);
            __builtin_amdgcn_fence(__ATOMIC_ACQUIRE, "agent");
            asm volatile("s_waitcnt vmcnt(0)" ::: "memory");
        }
    }
    __syncthreads();
}

DI void phase_prep(const Params& p, LAS unsigned char* lds) {
    const int tid = threadIdx.x, wid = tid >> 6, lane = tid & 63;
    unsigned char* ws = p.ws;
    if (blockIdx.x == 0 && tid < 128) ((unsigned*)(ws + WS_CNT))[tid] = 0u;
    {
        bf16_t* hb = (bf16_t*)(ws + WS_HB);
        for (int row = (blockIdx.x * 8 + wid) * 2; row < NTOK; row += gridDim.x * 16) {
            const f32x4* xr = (const f32x4*)(p.x + (size_t)row * DM);
            f32x4 v[2][8]; float ss[2] = {0.f, 0.f};
#pragma unroll
            for (int rr = 0; rr < 2; ++rr)
#pragma unroll
                for (int i = 0; i < 8; ++i) v[rr][i] = __builtin_nontemporal_load(xr + rr * (DM / 4) + lane + 64 * i);
#pragma unroll
            for (int rr = 0; rr < 2; ++rr) {
#pragma unroll
                for (int i = 0; i < 8; ++i) ss[rr] += v[rr][i][0] * v[rr][i][0] + v[rr][i][1] * v[rr][i][1] + v[rr][i][2] * v[rr][i][2] + v[rr][i][3] * v[rr][i][3];
                ss[rr] = wave_sum(ss[rr]);
            }
#pragma unroll
            for (int rr = 0; rr < 2; ++rr) {
                const float rstd = rsqrtf(ss[rr] * (1.f / DM) + EPS);
#pragma unroll
                for (int i = 0; i < 8; ++i) {
                    u32x2 w; w.x = pk2(v[rr][i][0] * rstd, v[rr][i][1] * rstd); w.y = pk2(v[rr][i][2] * rstd, v[rr][i][3] * rstd);
                    *(u32x2*)(hb + (size_t)(row + rr) * DM + (lane + 64 * i) * 4) = w;
                }
            }
        }
    }
    {
        bf16_t* wtin = (bf16_t*)(ws + WS_WTIN); bf16_t* wtout = (bf16_t*)(ws + WS_WTOUT);
        for (int g4 = blockIdx.x; g4 < (4096 + 1024) / 4; g4 += gridDim.x) {
            f32x4 v[4][2]; float gg[4][2];
#pragma unroll
            for (int q = 0; q < 4; ++q) {
                const int t = g4 * 4 + q;
                const bool isin = t < 4096;
                const int tt = isin ? t : t - 4096;
                const int ncols = isin ? INC : DM;
                const int ntn = ncols / 64;
                const int kt = tt / ntn, nt = tt % ntn, k0 = kt * 64, n0 = nt * 64;
                const float* src = isin ? p.w_in : p.w_out;
#pragma unroll
                for (int ps = 0; ps < 2; ++ps) {
                    const int i = (tid >> 4) + 32 * ps, c4 = (tid & 15) * 4;
                    v[q][ps] = __builtin_nontemporal_load((const f32x4*)(src + (size_t)(k0 + i) * ncols + n0 + c4));
                    gg[q][ps] = isin ? p.ng[k0 + i] : 1.f;
                }
            }
#pragma unroll
            for (int q = 0; q < 4; ++q) {
                LAS float* tile = (LAS float*)(lds + q * 16640);
#pragma unroll
                for (int ps = 0; ps < 2; ++ps) {
                    const int i = (tid >> 4) + 32 * ps, c4 = (tid & 15) * 4;
                    const float g = gg[q][ps];
                    tile[i * 65 + c4 + 0] = v[q][ps][0] * g; tile[i * 65 + c4 + 1] = v[q][ps][1] * g; tile[i * 65 + c4 + 2] = v[q][ps][2] * g; tile[i * 65 + c4 + 3] = v[q][ps][3] * g;
                }
            }
            __syncthreads();
#pragma unroll
            for (int q = 0; q < 4; ++q) {
                const int t = g4 * 4 + q;
                const bool isin = t < 4096;
                const int tt = isin ? t : t - 4096;
                const int ntn = (isin ? INC : DM) / 64;
                const int kt = tt / ntn, nt = tt % ntn, k0 = kt * 64, n0 = nt * 64;
                LAS float* tile = (LAS float*)(lds + q * 16640);
                const int nl = tid >> 3, ks = tid & 7;
                float f[8];
#pragma unroll
                for (int j = 0; j < 8; ++j) f[j] = tile[(ks * 8 + j) * 65 + nl];
                u32x4 w; w.x = pk2(f[0], f[1]); w.y = pk2(f[2], f[3]); w.z = pk2(f[4], f[5]); w.w = pk2(f[6], f[7]);
                const int dr = isin ? dst_row_in(n0 + nl) : dst_row_out(n0 + nl);
                bf16_t* dst = (isin ? wtin : wtout) + (size_t)dr * DM + k0 + ks * 8;
                *(u32x4*)dst = w;
            }
            __syncthreads();
        }
    }
}

constexpr int BM = 256, BK = 64, HALF = 128, HTB = HALF * BK * 2, NXCD = 8, WGM = 8;
__host__ __device__ __forceinline__ int lds_byte(int r, int c) { const int st = (r >> 4) * 2 + (c >> 5), rr = r & 15, cc = c & 31, ob = rr * 64 + cc * 2; return st * 1024 + (ob ^ (((ob >> 9) & 1) << 5)); }
__host__ __device__ __forceinline__ void stage_rc(int b, int& R, int& C) { const int st = b / 1024, sb = b % 1024, swz = sb ^ (((sb >> 9) & 1) << 5); R = (st >> 1) * 16 + swz / 64; C = (st & 1) * 32 + (swz % 64) / 2; }
struct Unit { int pm, pn; };
DI bool next_unit(int i, int nM, int nN, Unit& u, int mode) {
    if (mode == 1) {
        if (i >= 4) return false;
        const int c = blockIdx.x, x = c & 7, j = c >> 3;
        u.pm = (i * 8 + x) * 4 + (j >> 3); u.pn = j & 7; return true;
    }
    const int nwg = nM * nN; const long L = (long)i * gridDim.x + blockIdx.x; if (L >= nwg) return false;
    int wgid = (int)L; { const int q = nwg / NXCD, r = nwg % NXCD, xcd = wgid % NXCD, off = wgid / NXCD; wgid = (xcd < r ? xcd * (q + 1) : r * (q + 1) + (xcd - r) * q) + off; }
    const int nig = WGM * nN, gid = wgid / nig, fm = gid * WGM, gsz = (nM - fm) < WGM ? (nM - fm) : WGM;
    u.pm = fm + ((wgid % nig) % gsz); u.pn = (wgid % nig) / gsz; return true;
}

template <class Epi>
DI void gemm_phase(LAS unsigned char* lds, const bf16_t* gA, const bf16_t* gBt, int M, int N, int K, const Epi& E, int mode) {
    const int tid = threadIdx.x, wid = __builtin_amdgcn_readfirstlane(tid >> 6), lane = tid & 63, wr = wid >> 2, wc = wid & 3, fr = lane & 15, fq = lane >> 4;
    const int nt = K / BK, nM = M / BM, nN = N / BM;
    unsigned voffA[2], voffB[2];
#pragma unroll
    for (int i = 0; i < 2; ++i) { int R, C; stage_rc(tid * 16 + i * 8192, R, C); const int Rp = (R & 64) | ((R & 15) << 2) | ((R >> 4) & 3);
        voffA[i] = (unsigned)(Rp * K + C) * 2u; voffB[i] = (unsigned)(R * K + C) * 2u; }
    const size_t kstep = (size_t)(BK * 2);
    const size_t hstep = (size_t)HALF * K * 2;
    const size_t tstep = 2 * hstep;
    const unsigned ldsw = (unsigned)wid * 1024u;
    const int aoff = lds_byte(wr * 64 + fr, fq * 8), boff = lds_byte(wc * 32 + fr, fq * 8);
#define PG8_SA(b, h) (((b) * 2 + (h)) * HTB)
#define PG8_SB(b, h) ((4 + (b) * 2 + (h)) * HTB)
#define PG8_STAGE(bufoff, gbase, voff) do { _Pragma("unroll") for (int _i = 0; _i < 2; ++_i) \
        __builtin_amdgcn_global_load_lds((const unsigned*)((const char*)(gbase) + (voff)[_i]), (LAS unsigned*)(lds + (bufoff) + ldsw + _i * 8192), 16, 0, 0); } while (0)
#define PG8_LDA(dst, b, h) do { _Pragma("unroll") for (int m = 0; m < 4; ++m) _Pragma("unroll") for (int k = 0; k < 2; ++k) dst[m][k] = *(const LAS bf16x8*)(lds + PG8_SA(b, h) + aoff + m * 2048 + k * 1024); } while (0)
#define PG8_LDB(dst, b, h) do { _Pragma("unroll") for (int n = 0; n < 2; ++n) _Pragma("unroll") for (int k = 0; k < 2; ++k) dst[n][k] = *(const LAS bf16x8*)(lds + PG8_SB(b, h) + boff + n * 2048 + k * 1024); } while (0)
#define PG8_MMA(ai, bj, At, Bt) do { __builtin_amdgcn_s_setprio(1); _Pragma("unroll") for (int m = 0; m < 4; ++m) _Pragma("unroll") for (int n = 0; n < 2; ++n) _Pragma("unroll") for (int k = 0; k < 2; ++k) \
        acc[ai][bj][m][n] = __builtin_amdgcn_mfma_f32_16x16x32_bf16(Bt[n][k], At[m][k], acc[ai][bj][m][n], 0, 0, 0); __builtin_amdgcn_s_setprio(0); } while (0)
#define PG8_WAIT_V(n) asm volatile("s_waitcnt vmcnt(" #n ")" ::: "memory")
#define PG8_WAIT_L(n) asm volatile("s_waitcnt lgkmcnt(" #n ")" ::: "memory")
#define PG8_BAR __builtin_amdgcn_s_barrier()
#define PG8_SCHED __builtin_amdgcn_sched_barrier(0)
    Unit cur, nxt; int ui = 0;
    if (!next_unit(0, nM, nN, cur, mode)) return;
    f32x4 acc[2][2][4][2];
    E.init(acc, cur, wr, wc, fr, fq);
    bf16x8 At[4][2], B0[2][2], B1[2][2];
    const char* cA = (const char*)gA + (size_t)cur.pm * tstep; const char* cB = (const char*)gBt + (size_t)cur.pn * tstep;
    PG8_STAGE(PG8_SB(0, 0), cB, voffB); PG8_STAGE(PG8_SA(0, 0), cA, voffA); PG8_STAGE(PG8_SB(0, 1), cB + hstep, voffB); PG8_STAGE(PG8_SA(0, 1), cA + hstep, voffA);
    if (wr == 1) PG8_BAR;
    PG8_WAIT_V(4); PG8_BAR;
    PG8_STAGE(PG8_SB(1, 0), cB + kstep, voffB); PG8_STAGE(PG8_SA(1, 0), cA + kstep, voffA); PG8_STAGE(PG8_SB(1, 1), cB + hstep + kstep, voffB);
    PG8_WAIT_V(6); PG8_BAR;
    for (;;) {
        const bool has_next = next_unit(ui + 1, nM, nN, nxt, mode);
        const char* nA = has_next ? (const char*)gA + (size_t)nxt.pm * tstep : cA; const char* nB = has_next ? (const char*)gBt + (size_t)nxt.pn * tstep : cB;
        for (int t = 0; t < nt; t += 2) {
            const bool last = (t == nt - 2);
            const char* a1 = cA + (size_t)(t + 1) * kstep;
            const char* a2 = last ? nA : cA + (size_t)(t + 2) * kstep; const char* b2 = last ? nB : cB + (size_t)(t + 2) * kstep;
            const char* a3 = a2 + kstep; const char* b3 = b2 + kstep;
            PG8_LDB(B0, 0, 0); PG8_SCHED; PG8_LDA(At, 0, 0); PG8_STAGE(PG8_SA(1, 1), a1 + hstep, voffA);
            PG8_WAIT_L(8); PG8_BAR; PG8_WAIT_L(0); PG8_MMA(0, 0, At, B0); PG8_BAR; PG8_SCHED;
            PG8_LDB(B1, 0, 1); PG8_STAGE(PG8_SB(0, 0), b2, voffB);
            PG8_BAR; PG8_WAIT_L(0); PG8_MMA(0, 1, At, B1); PG8_BAR;
            PG8_LDA(At, 0, 1); PG8_STAGE(PG8_SA(0, 0), a2, voffA);
            PG8_BAR; PG8_WAIT_L(0); PG8_MMA(1, 0, At, B0); PG8_BAR; PG8_SCHED;
            PG8_STAGE(PG8_SB(0, 1), b2 + hstep, voffB);
            PG8_WAIT_V(6); PG8_BAR; PG8_MMA(1, 1, At, B1); PG8_BAR;
            PG8_LDB(B0, 1, 0); PG8_SCHED; PG8_LDA(At, 1, 0); PG8_STAGE(PG8_SA(0, 1), a2 + hstep, voffA);
            PG8_WAIT_L(8); PG8_BAR; PG8_WAIT_L(0); PG8_MMA(0, 0, At, B0); PG8_BAR; PG8_SCHED;
            PG8_LDB(B1, 1, 1); PG8_STAGE(PG8_SB(1, 0), b3, voffB);
            PG8_BAR; PG8_WAIT_L(0); PG8_MMA(0, 1, At, B1); PG8_BAR;
            PG8_LDA(At, 1, 1); PG8_STAGE(PG8_SA(1, 0), a3, voffA);
            PG8_BAR; PG8_WAIT_L(0); PG8_MMA(1, 0, At, B0); PG8_BAR; PG8_SCHED;
            PG8_STAGE(PG8_SB(1, 1), b3 + hstep, voffB);
            PG8_WAIT_V(6); PG8_BAR; PG8_MMA(1, 1, At, B1); PG8_BAR;
        }
        if (Epi::REALIGN) { if (wr == 0) PG8_BAR; }
        E(acc, cur, wr, wc, fr, fq);
        if (Epi::REALIGN) { if (wr == 1) PG8_BAR; }
        if (!has_next) break;
        E.init(acc, nxt, wr, wc, fr, fq);
        cur = nxt; cA = nA; cB = nB; ++ui;
    }
    PG8_WAIT_V(0);
    if (wr == 0) PG8_BAR;
    PG8_BAR;
#undef PG8_SA
#undef PG8_SB
#undef PG8_STAGE
#undef PG8_LDA
#undef PG8_LDB
#undef PG8_MMA
#undef PG8_WAIT_V
#undef PG8_WAIT_L
#undef PG8_BAR
#undef PG8_SCHED
}

struct Epi1 {
    static constexpr bool REALIGN = false;
    unsigned char* ws;
    DI void init(f32x4 (&acc)[2][2][4][2], const Unit&, int, int, int, int) const {
#pragma unroll
        for (int a = 0; a < 2; ++a)
#pragma unroll
            for (int b = 0; b < 2; ++b)
#pragma unroll
                for (int m = 0; m < 4; ++m)
#pragma unroll
                    for (int n = 0; n < 2; ++n) acc[a][b][m][n] = (f32x4){0.f, 0.f, 0.f, 0.f};
    }
    DI void operator()(f32x4 (&acc)[2][2][4][2], const Unit& u, int wr, int wc, int fr, int fq) const {
        const int grp = u.pn >> 2, hb = (u.pn & 3) * 2;
        const int rowt = u.pm * BM + wr * 64 + 4 * fr;
        const int b = rowt >> 12;
        const int sl0 = wr * 64 + 4 * fr;
        if (grp < 2) {
            bf16_t* dst = (bf16_t*)(ws + (grp == 0 ? WS_RQ : WS_RK));
            bf16_t* ktz = (bf16_t*)(ws + WS_KTZ);
            const int a0 = 16 * wc + 4 * fq;
            float invrev[4];
#pragma unroll
            for (int j = 0; j < 4; ++j) invrev[j] = ex2(-(float)(a0 + j) * (13.287712379549449f / 64.f)) * 0.15915494309189535f;
#pragma unroll
            for (int ai = 0; ai < 2; ++ai) {
                const int c = (u.pm * 2 + ai) & 31;
                f32x4 cc[4], sn[4];
#pragma unroll
                for (int m = 0; m < 4; ++m) {
                    const float sf = (float)((rowt + ai * HALF + m) & 4095);
#pragma unroll
                    for (int j = 0; j < 4; ++j) {
                        const float rv = sf * invrev[j];
                        const float fr_ = rv - __builtin_floorf(rv);
                        cc[m][j] = __builtin_amdgcn_cosf(fr_); sn[m][j] = __builtin_amdgcn_sinf(fr_);
                    }
                }
#pragma unroll
                for (int bj = 0; bj < 2; ++bj) {
                    const int head = hb + bj;
                    f32x4 o1[4], o2[4];
#pragma unroll
                    for (int m = 0; m < 4; ++m) {
                        const int s = (rowt + ai * HALF + m) & 4095;
                        const f32x4 c4 = cc[m], s4 = sn[m];
                        const f32x4 v1 = acc[ai][bj][m][0], v2 = acc[ai][bj][m][1];
                        o1[m] = v1 * c4 - v2 * s4; o2[m] = v1 * s4 + v2 * c4;
                        if (grp == 1) { o1[m] *= KSCALE; o2[m] *= KSCALE; }
                        bf16_t* rp = dst + ((size_t)(b * 8 + head) * SEQ + s) * HD + a0;
                        u32x2 w1, w2; w1.x = pk2(o1[m][0], o1[m][1]); w1.y = pk2(o1[m][2], o1[m][3]); w2.x = pk2(o2[m][0], o2[m][1]); w2.y = pk2(o2[m][2], o2[m][3]);
                        *(u32x2*)rp = w1; *(u32x2*)(rp + 64) = w2;
                    }
                    if (grp == 1) {
                        const float l2g = l2gamma(head);
                        float z[4];
#pragma unroll
                        for (int m = 0; m < 4; ++m) z[m] = ex2(l2g * (float)(127 - (sl0 + m)));
                        bf16_t* kt = ktz + (((size_t)(b * 8 + head) * 32 + c) * HD + a0) * 128 + sl0;
#pragma unroll
                        for (int j = 0; j < 4; ++j) {
                            u32x2 w1, w2;
                            w1.x = pk2(o1[0][j] * z[0], o1[1][j] * z[1]); w1.y = pk2(o1[2][j] * z[2], o1[3][j] * z[3]);
                            w2.x = pk2(o2[0][j] * z[0], o2[1][j] * z[1]); w2.y = pk2(o2[2][j] * z[2], o2[3][j] * z[3]);
                            *(u32x2*)(kt + j * 128) = w1; *(u32x2*)(kt + (64 + j) * 128) = w2;
                        }
                    }
                }
            }
        } else if (grp == 2 || grp == 6) {
            bf16_t* dst = (bf16_t*)(ws + (grp == 2 ? WS_RVT : WS_SVT));
#pragma unroll
            for (int ai = 0; ai < 2; ++ai) {
                const int c = (u.pm * 2 + ai) & 31;
#pragma unroll
                for (int bj = 0; bj < 2; ++bj) {
                    bf16_t* vt = (grp == 2) ? dst + (((size_t)(b * 8 + hb + bj) * 32 + c) * HD + 32 * wc + 8 * fq) * 128 + sl0
                                            : dst + (((size_t)(b * 8 + hb + bj) * 128 + c * 4 + (sl0 >> 5)) * HD + 32 * wc + 8 * fq) * 32 + (sl0 & 31);
                    const int rs = (grp == 2) ? 128 : 32;
#pragma unroll
                    for (int n = 0; n < 2; ++n)
#pragma unroll
                        for (int j = 0; j < 4; ++j) {
                            u32x2 w; w.x = pk2(acc[ai][bj][0][n][j], acc[ai][bj][1][n][j]); w.y = pk2(acc[ai][bj][2][n][j], acc[ai][bj][3][n][j]);
                            *(u32x2*)(vt + (4 * n + j) * rs) = w;
                        }
                }
            }
        } else {
            bf16_t* dst = (bf16_t*)(ws + (grp == 3 ? WS_RG : grp == 4 ? WS_SQ : grp == 5 ? WS_SK : WS_SG));
            const bool gate = (grp == 3 || grp == 7);
            const float sc = (grp == 4) ? KSCALE * LOG2E : 1.0f;
#pragma unroll
            for (int ai = 0; ai < 2; ++ai)
#pragma unroll
                for (int m = 0; m < 4; ++m) {
                    const int s = (rowt + ai * HALF + m) & 4095;
#pragma unroll
                    for (int bj = 0; bj < 2; ++bj) {
                        f32x4 v0 = acc[ai][bj][m][0] * sc, v1 = acc[ai][bj][m][1] * sc;
                        if (gate) {
#pragma unroll
                            for (int j = 0; j < 4; ++j) { v0[j] = silu(v0[j]); v1[j] = silu(v1[j]); }
                        }
                        u32x4 w; w.x = pk2(v0[0], v0[1]); w.y = pk2(v0[2], v0[3]); w.z = pk2(v1[0], v1[1]); w.w = pk2(v1[2], v1[3]);
                        *(u32x4*)(dst + ((size_t)(b * 8 + hb + bj) * SEQ + s) * HD + 32 * wc + 8 * fq) = w;
                    }
                }
        }
    }
};

struct Epi2 {
    static constexpr bool REALIGN = false;
    const float* x; float* out; float* ssp;
    DI void init(f32x4 (&acc)[2][2][4][2], const Unit&, int, int, int, int) const {
#pragma unroll
        for (int a = 0; a < 2; ++a)
#pragma unroll
            for (int b = 0; b < 2; ++b)
#pragma unroll
                for (int m = 0; m < 4; ++m)
#pragma unroll
                    for (int n = 0; n < 2; ++n) acc[a][b][m][n] = (f32x4){0.f, 0.f, 0.f, 0.f};
    }
    DI void operator()(f32x4 (&acc)[2][2][4][2], const Unit& u, int wr, int wc, int fr, int fq) const {
        const int rowt = u.pm * BM + wr * 64 + 4 * fr;
#pragma unroll
        for (int ai = 0; ai < 2; ++ai) {
            f32x4 xv[4][2][2];
#pragma unroll
            for (int m = 0; m < 4; ++m)
#pragma unroll
                for (int bj = 0; bj < 2; ++bj)
#pragma unroll
                    for (int n = 0; n < 2; ++n)
                        xv[m][bj][n] = *(const f32x4*)(x + (size_t)(rowt + ai * HALF + m) * DM + u.pn * BM + bj * HALF + 32 * wc + 8 * fq + 4 * n);
#pragma unroll
            for (int m = 0; m < 4; ++m) {
                const int row = rowt + ai * HALF + m;
                float ss = 0.f;
#pragma unroll
                for (int bj = 0; bj < 2; ++bj)
#pragma unroll
                    for (int n = 0; n < 2; ++n) {
                        const size_t o = (size_t)row * DM + u.pn * BM + bj * HALF + 32 * wc + 8 * fq + 4 * n;
                        const f32x4 y = xv[m][bj][n] + acc[ai][bj][m][n];
                        *(f32x4*)(out + o) = y;
                        ss += y[0] * y[0] + y[1] * y[1] + y[2] * y[2] + y[3] * y[3];
                    }
                ss += __shfl_xor(ss, 16); ss += __shfl_xor(ss, 32);
                if (fq == 0) ssp[(size_t)row * 32 + u.pn * 4 + wc] = ss;
            }
        }
    }
};


struct Epi2F {
    static constexpr bool REALIGN = true;
    const float* x; float* out; float* ssp; unsigned* cnt; const float* fg; LAS float* xl;
    DI void init(f32x4 (&acc)[2][2][4][2], const Unit& u, int wr, int wc, int fr, int fq) const {
        const float* xp = x + (size_t)(u.pm * BM + wr * 64 + 4 * fr) * DM + u.pn * BM + 32 * wc + 8 * fq;
#pragma unroll
        for (int ai = 0; ai < 2; ++ai)
#pragma unroll
            for (int bj = 0; bj < 2; ++bj)
#pragma unroll
                for (int m = 0; m < 4; ++m)
#pragma unroll
                    for (int n = 0; n < 2; ++n) acc[ai][bj][m][n] = __builtin_nontemporal_load((const f32x4*)(xp + (size_t)(ai * HALF + m) * DM + bj * HALF + 4 * n));
    }
    DI void operator()(f32x4 (&acc)[2][2][4][2], const Unit& u, int wr, int wc, int fr, int fq) const {
        const int tid = threadIdx.x;
        const int rl = wr * 64 + 4 * fr;
        const int rowt = u.pm * BM + rl;
        const int colt = u.pn * BM + 32 * wc + 8 * fq;
#pragma unroll
        for (int ai = 0; ai < 2; ++ai)
#pragma unroll
            for (int m = 0; m < 4; ++m) {
                float ss = 0.f;
#pragma unroll
                for (int bj = 0; bj < 2; ++bj)
#pragma unroll
                    for (int n = 0; n < 2; ++n) { const f32x4 y = acc[ai][bj][m][n]; ss += y[0] * y[0] + y[1] * y[1] + y[2] * y[2] + y[3] * y[3]; }
                ss += __shfl_xor(ss, 16); ss += __shfl_xor(ss, 32);
                if (fq == 0) xl[wc * 256 + rl + ai * HALF + m] = ss;
            }
        __syncthreads();
        if (tid < 256) {
            const float s = (xl[tid] + xl[256 + tid]) + (xl[512 + tid] + xl[768 + tid]);
            __hip_atomic_store(ssp + (size_t)(u.pm * BM + tid) * 8 + u.pn, s, __ATOMIC_RELAXED, __HIP_MEMORY_SCOPE_AGENT);
        }
        asm volatile("s_waitcnt vmcnt(0)" ::: "memory");
        __syncthreads();
        if (tid == 0) {
            __hip_atomic_fetch_add(cnt + u.pm, 1u, __ATOMIC_RELAXED, __HIP_MEMORY_SCOPE_AGENT);
            while (__hip_atomic_load(cnt + u.pm, __ATOMIC_RELAXED, __HIP_MEMORY_SCOPE_AGENT) < 8u) __builtin_amdgcn_s_sleep(4);
        }
        __syncthreads();
        if (tid < 256) {
            const float* sp = ssp + (size_t)(u.pm * BM + tid) * 8;
            float s = 0.f;
#pragma unroll
            for (int k = 0; k < 8; ++k) s += __hip_atomic_load(sp + k, __ATOMIC_RELAXED, __HIP_MEMORY_SCOPE_AGENT);
            xl[1024 + tid] = rsqrtf(s * (1.f / DM) + EPS);
        }
        __syncthreads();
        f32x4 g[2][2];
#pragma unroll
        for (int bj = 0; bj < 2; ++bj)
#pragma unroll
            for (int n = 0; n < 2; ++n) g[bj][n] = *(const f32x4*)(fg + colt + bj * HALF + 4 * n);
#pragma unroll
        for (int ai = 0; ai < 2; ++ai)
#pragma unroll
            for (int m = 0; m < 4; ++m) {
                const float rstd = xl[1024 + rl + ai * HALF + m];
#pragma unroll
                for (int bj = 0; bj < 2; ++bj)
#pragma unroll
                    for (int n = 0; n < 2; ++n)
                        *(f32x4*)(out + (size_t)(rowt + ai * HALF + m) * DM + colt + bj * HALF + 4 * n) = acc[ai][bj][m][n] * rstd * g[bj][n];
            }
    }
};

DI void sb_unit(const Params& p, int wu, int lane, LAS unsigned char* wl, const LAS float* sbgl) {
    unsigned char* ws = p.ws;
    const int bh = wu >> 7, tb = wu & 127, t0 = tb * 32, r = lane & 31, hh = lane >> 5, h = bh & 7, b = bh >> 3;
    const int pr = 16 * ((r >> 2) & 1) + 4 * (r >> 3) + (r & 3);
    const bf16_t* qp = (const bf16_t*)(ws + WS_SQ) + ((size_t)bh * SEQ + t0 + r) * HD + hh * 8;
    const int krow = lane >> 4, kpos = lane & 15;
    const int vrow = lane >> 2, vpos = lane & 3;
    const char* ksrc = (const char*)((const bf16_t*)(ws + WS_SK) + (size_t)bh * SEQ * HD);
    const char* vsrc = (const char*)((const bf16_t*)(ws + WS_SVT) + (size_t)bh * 32 * HD * 128);
    LAS unsigned char* Kw = wl; LAS unsigned char* Vw = wl + 8192;
    int koff[8], voff[4][2];
    {
        const int f = (pr & 7) + 8 * (pr >> 4);
#pragma unroll
        for (int ks = 0; ks < 8; ++ks) koff[ks] = pr * 256 + (((2 * ks + hh) ^ f) * 16);
#pragma unroll
        for (int et = 0; et < 4; ++et)
#pragma unroll
            for (int s2 = 0; s2 < 2; ++s2) { const int row = et * 32 + r; voff[et][s2] = row * 64 + (((2 * hh + s2) ^ ((row >> 2) & 3)) * 16); }
    }
    const int kcb16 = (kpos ^ krow) * 16;
    const int vc16 = (vpos ^ ((vrow >> 2) & 3)) * 16;
    const int kx0 = krow * 256 + (kcb16 ^ 0), kx1 = krow * 256 + (kcb16 ^ 64), kx2 = krow * 256 + (kcb16 ^ 128) + 4096, kx3 = krow * 256 + (kcb16 ^ 192) + 4096;
    const int vx0 = vrow * 64 + vc16;
#define SB_DMA(P, L, OFF) __builtin_amdgcn_global_load_lds((const unsigned*)(P), (LAS unsigned*)(L), 16, OFF, 0)
#define SB_ISSUE_K(S0) do { const char* _b = ksrc + (size_t)(S0) * 256; \
        const char* _p0 = _b + kx0; const char* _p1 = _b + kx1; const char* _p2 = _b + kx2; const char* _p3 = _b + kx3; \
        SB_DMA(_p0, Kw, 0); SB_DMA(_p1, Kw, 1024); SB_DMA(_p0, Kw, 2048); SB_DMA(_p1, Kw, 3072); \
        SB_DMA(_p2, Kw + 4096, 0); SB_DMA(_p3, Kw + 4096, 1024); SB_DMA(_p2, Kw + 4096, 2048); SB_DMA(_p3, Kw + 4096, 3072); } while (0)
#define SB_ISSUE_V(S0) do { const char* _p = vsrc + (size_t)((S0) >> 5) * 8192 + vx0; const char* _q = _p + 4096; \
        SB_DMA(_p, Vw, 0); SB_DMA(_p, Vw, 1024); SB_DMA(_p, Vw, 2048); SB_DMA(_p, Vw, 3072); \
        SB_DMA(_q, Vw + 4096, 0); SB_DMA(_q, Vw + 4096, 1024); SB_DMA(_q, Vw + 4096, 2048); SB_DMA(_q, Vw + 4096, 3072); } while (0)
    asm volatile("s_waitcnt vmcnt(0)" ::: "memory");
    SB_ISSUE_K(t0); SB_ISSUE_V(t0);
    bf16x8 qf[8];
#pragma unroll
    for (int ks = 0; ks < 8; ++ks) qf[ks] = *(const bf16x8*)(qp + ks * 16);
    f32x16 o[4];
#pragma unroll
    for (int et = 0; et < 4; ++et)
#pragma unroll
        for (int i = 0; i < 16; ++i) o[et][i] = 0.f;
    float carry = 1.f;
    asm volatile("s_waitcnt vmcnt(0)" ::: "memory");
    for (int s0 = t0; s0 >= 0; s0 -= 32) {
        const bool more = (s0 >= 32);
        f32x16 st;
        {
            bf16x8 kf[8];
            asm volatile("s_waitcnt vmcnt(8)" ::: "memory");
#pragma unroll
            for (int ks = 0; ks < 8; ++ks) kf[ks] = *(const LAS bf16x8*)(Kw + koff[ks]);
            asm volatile("s_waitcnt lgkmcnt(0)" ::: "memory");
            if (more) SB_ISSUE_K(s0 - 32);
#pragma unroll
            for (int i = 0; i < 16; ++i) st[i] = 0.f;
            __builtin_amdgcn_s_setprio(1);
#pragma unroll
            for (int ks = 0; ks < 8; ++ks) st = MFMA32(kf[ks], qf[ks], st);
            __builtin_amdgcn_s_setprio(0);
        }
        const bool diag = (s0 == t0);
        const int kbase_i = 16 * hh;
        float exs[16], bt[16];
        float run = 1.f;
#pragma unroll
        for (int i = 15; i >= 0; --i) {
            const float z = __builtin_amdgcn_fmed3f(st[i], -60.f, 60.f);
            const float en = ex2(-z);
            float bta = __builtin_amdgcn_rcpf(1.f + en);
            float kp = en * bta;
            if (diag) { const bool ok = (kbase_i + i < r); bta = ok ? bta : 0.f; kp = ok ? kp : 1.f; }
            exs[i] = run; bt[i] = bta;
            run *= kp;
        }
        const float T = run;
        const float U = __shfl_xor(T, 32);
        const float off = carry * (hh == 0 ? U : 1.f);
        float a[16];
#pragma unroll
        for (int i = 0; i < 16; ++i) a[i] = bt[i] * (off * exs[i]);
        carry *= T * U;
        {
            bf16x8 vf[4][2];
            if (more) asm volatile("s_waitcnt vmcnt(8)" ::: "memory"); else asm volatile("s_waitcnt vmcnt(0)" ::: "memory");
#pragma unroll
            for (int et = 0; et < 4; ++et)
#pragma unroll
                for (int s2 = 0; s2 < 2; ++s2) vf[et][s2] = *(const LAS bf16x8*)(Vw + voff[et][s2]);
            asm volatile("s_waitcnt lgkmcnt(0)" ::: "memory");
            if (more) SB_ISSUE_V(s0 - 32);
            __builtin_amdgcn_s_setprio(1);
#pragma unroll
            for (int s2 = 0; s2 < 2; ++s2) {
                u32x4 pw; pw.x = pk2(a[8 * s2], a[8 * s2 + 1]); pw.y = pk2(a[8 * s2 + 2], a[8 * s2 + 3]); pw.z = pk2(a[8 * s2 + 4], a[8 * s2 + 5]); pw.w = pk2(a[8 * s2 + 6], a[8 * s2 + 7]);
                const bf16x8 pf = __builtin_bit_cast(bf16x8, pw);
#pragma unroll
                for (int et = 0; et < 4; ++et) o[et] = MFMA32(vf[et][s2], pf, o[et]);
            }
            __builtin_amdgcn_s_setprio(0);
        }
        if (__all(carry < 1.17549435e-38f)) break;
    }
#undef SB_ISSUE_K
#undef SB_ISSUE_V
#undef SB_DMA

    float ss = 0.f;
#pragma unroll
    for (int et = 0; et < 4; ++et)
#pragma unroll
        for (int i = 0; i < 16; ++i) ss += o[et][i] * o[et][i];
    ss += __shfl_xor(ss, 32);
    const float rstd = rsqrtf(ss * (1.f / HD) + EPS);
    const int t = t0 + r;
    const bf16_t* gp = (const bf16_t*)(ws + WS_SG) + ((size_t)bh * SEQ + t) * HD;
    bf16_t* mp = (bf16_t*)(ws + WS_MIX) + ((size_t)(b * SEQ + t)) * DM + 1024 + h * HD;
    u32x2 gw[4][4];
#pragma unroll
    for (int et = 0; et < 4; ++et)
#pragma unroll
        for (int q = 0; q < 4; ++q) gw[et][q] = *(const u32x2*)(gp + et * 32 + 8 * q + 4 * hh);
    u32x2 wv[16];
#pragma unroll
    for (int et = 0; et < 4; ++et)
#pragma unroll
        for (int q = 0; q < 4; ++q) {
            const int e = et * 32 + 8 * q + 4 * hh;
            const f32x4 gn = *(const LAS f32x4*)(sbgl + h * HD + e);
            const float g0 = __uint_as_float(gw[et][q].x << 16), g1 = __uint_as_float(gw[et][q].x & 0xffff0000u), g2 = __uint_as_float(gw[et][q].y << 16), g3 = __uint_as_float(gw[et][q].y & 0xffff0000u);
            u32x2 w;
            w.x = pk2(o[et][4 * q] * rstd * gn[0] * g0, o[et][4 * q + 1] * rstd * gn[1] * g1);
            w.y = pk2(o[et][4 * q + 2] * rstd * gn[2] * g2, o[et][4 * q + 3] * rstd * gn[3] * g3);
            wv[et * 4 + q] = w;
        }
#pragma unroll
    for (int k = 0; k < 16; k += 2) {
        const auto rx = __builtin_amdgcn_permlane32_swap(wv[k].x, wv[k + 1].x, false, false);
        const auto ry = __builtin_amdgcn_permlane32_swap(wv[k].y, wv[k + 1].y, false, false);
        u32x4 st4; st4.x = rx[0]; st4.y = ry[0]; st4.z = rx[1]; st4.w = ry[1];
        *(u32x4*)(mp + 8 * k + 8 * hh) = st4;
    }
}

DI void blk_load4(u32x4 (&r)[4], const bf16_t* g, int tid) {
#pragma unroll
    for (int i = 0; i < 4; ++i) r[i] = __builtin_nontemporal_load((const u32x4*)(g + (size_t)(tid + 512 * i) * 8));
}
DI void blk_store4(LAS unsigned char* l, const u32x4 (&r)[4], int tid) {
#pragma unroll
    for (int i = 0; i < 4; ++i) { const int ch = tid + 512 * i; *(LAS u32x4*)(l + (ch >> 4) * 272 + (ch & 15) * 16) = r[i]; }
}
constexpr int TB = 128 * 272;

DI void state2(const Params& p, int w, int lane) {
    unsigned char* ws = p.ws;
    const int fr = lane & 15, fq = lane >> 4;
    for (int u0 = blockIdx.x; u0 < 256; u0 += gridDim.x) {
        const int unit = (u0 & 7) * 32 + (u0 >> 3);
        const int bh = unit >> 2, eh = unit & 1, dh = (unit >> 1) & 1, h = bh & 7;
        const float gc = ex2(l2gamma(h) * 128.f);
        const int d0 = dh * 64, e0 = eh * 64 + w * 32;
        const bf16_t* kt = (const bf16_t*)(ws + WS_KTZ) + ((size_t)bh * 32 * HD + d0 + fr) * 128 + fq * 8;
        const bf16_t* vt = (const bf16_t*)(ws + WS_RVT) + ((size_t)bh * 32 * HD + e0 + fr) * 128 + fq * 8;
        bf16_t* rp0 = (bf16_t*)(ws + WS_RP) + ((size_t)bh * 32 * HD + e0 + fr) * 128 + d0;
        f32x4 R[2][4];
#pragma unroll
        for (int et = 0; et < 2; ++et)
#pragma unroll
            for (int dl = 0; dl < 4; ++dl) R[et][dl] = (f32x4){0.f, 0.f, 0.f, 0.f};
        bf16x8 kf[4][4], vf[2][4];
#define ST_LOAD(C) do { _Pragma("unroll") for (int ks = 0; ks < 4; ++ks) { \
            _Pragma("unroll") for (int dl = 0; dl < 4; ++dl) kf[dl][ks] = *(const bf16x8*)(kt + (size_t)(C) * 16384 + dl * 16 * 128 + ks * 32); \
            _Pragma("unroll") for (int et = 0; et < 2; ++et) vf[et][ks] = *(const bf16x8*)(vt + (size_t)(C) * 16384 + et * 16 * 128 + ks * 32); } } while (0)
        ST_LOAD(0);
#pragma unroll 1
        for (int c = 0; c < 32; ++c) {
            const int cn = (c + 1 < 32) ? c + 1 : 31;
            __builtin_amdgcn_sched_barrier(0);
#pragma unroll
            for (int et = 0; et < 2; ++et) {
#pragma unroll
                for (int dp = 0; dp < 4; dp += 2) {
                    const auto rx = __builtin_amdgcn_permlane16_swap(pk2(R[et][dp][0], R[et][dp][1]), pk2(R[et][dp + 1][0], R[et][dp + 1][1]), false, false);
                    const auto ry = __builtin_amdgcn_permlane16_swap(pk2(R[et][dp][2], R[et][dp][3]), pk2(R[et][dp + 1][2], R[et][dp + 1][3]), false, false);
                    u32x4 st4; st4.x = rx[0]; st4.y = ry[0]; st4.z = rx[1]; st4.w = ry[1];
                    *(u32x4*)(rp0 + (size_t)c * 16384 + et * 16 * 128 + 16 * (dp + (fq & 1)) + 8 * (fq >> 1)) = st4;
                }
#pragma unroll
                for (int dl = 0; dl < 4; ++dl) {
                    f32x4 a = {0.f, 0.f, 0.f, 0.f};
#pragma unroll
                    for (int ks = 0; ks < 4; ++ks) a = MFMA16(kf[dl][ks], vf[et][ks], a);
                    R[et][dl] = R[et][dl] * gc + a;
                }
            }
            __builtin_amdgcn_sched_barrier(0);
            ST_LOAD(cn);
            __builtin_amdgcn_sched_barrier(0);
        }
#undef ST_LOAD
    }
}

DI void phase_mix1(const Params& p, LAS unsigned char* lds) {
    const int wid = __builtin_amdgcn_readfirstlane(threadIdx.x >> 6), lane = threadIdx.x & 63;
    LAS unsigned* qctr = (LAS unsigned*)(lds + 131072 + 6144);
    if (threadIdx.x == 0) *qctr = 0u;
    LAS float* sbgl = (LAS float*)(lds + 131072);
    if (threadIdx.x < 256) *(LAS f32x4*)(sbgl + threadIdx.x * 4) = *(const f32x4*)(p.sbg + threadIdx.x * 4);
    __syncthreads();
    if (wid < 2) state2(p, wid, lane);
    const int per = (8192 + (int)gridDim.x - 1) / (int)gridDim.x;
    const int base = blockIdx.x * per, end = (base + per < 8192) ? base + per : 8192;
    for (;;) {
        unsigned k = 0;
        if (lane == 0) k = __hip_atomic_fetch_add(qctr, 1u, __ATOMIC_RELAXED, __HIP_MEMORY_SCOPE_WORKGROUP);
        k = __builtin_amdgcn_readfirstlane(k);
        if (base + (int)k >= end) break;
        sb_unit(p, base + (int)k, lane, lds + wid * 16384, sbgl);
    }
    asm volatile("s_waitcnt vmcnt(0)" ::: "memory");
}

DI void phase_mix2(const Params& p, LAS unsigned char* lds) {
    unsigned char* ws = p.ws;
    const int tid = threadIdx.x, w = __builtin_amdgcn_readfirstlane(tid >> 6), lane = tid & 63, fr = lane & 15, fq = lane >> 4, n0 = 16 * w;
    LAS unsigned char* Ks = lds; LAS unsigned char* Vs = lds + TB; LAS unsigned char* Rs = lds + 2 * TB;
    const bf16_t* gK = (const bf16_t*)(ws + WS_RK); const bf16_t* gV = (const bf16_t*)(ws + WS_RVT); const bf16_t* gR = (const bf16_t*)(ws + WS_RP);
    const bf16_t* gQ = (const bf16_t*)(ws + WS_RQ) + (size_t)(n0 + fr) * HD + fq * 8;
    LAS float* Gs = (LAS float*)(lds + 3 * TB);
    { const f32x4 a = *(const f32x4*)(p.gng + (tid & 255) * 4), bq = *(const f32x4*)(p.gnb + (tid & 255) * 4); if (tid < 256) *(LAS f32x4*)(Gs + tid * 4) = a; else *(LAS f32x4*)(Gs + 1024 + (tid - 256) * 4) = bq; }
    u32x4 rk[4], rv[4], rr[4]; bf16x8 qn[4];
    int u = blockIdx.x;
    if (u < 2048) {
        blk_load4(rk, gK + (size_t)u * 16384, tid); blk_load4(rv, gV + (size_t)u * 16384, tid); blk_load4(rr, gR + (size_t)u * 16384, tid);
#pragma unroll
        for (int ks = 0; ks < 4; ++ks) qn[ks] = *(const bf16x8*)(gQ + (size_t)u * 16384 + ks * 32);
    }
    for (; u < 2048; u += gridDim.x) {
        const int bh = u >> 5, c = u & 31, h = bh & 7, b = bh >> 3;
        blk_store4(Ks, rk, tid); blk_store4(Vs, rv, tid); blk_store4(Rs, rr, tid);
        bf16x8 qf[4];
#pragma unroll
        for (int ks = 0; ks < 4; ++ks) qf[ks] = qn[ks];
        __syncthreads();
        const int un = u + gridDim.x;
        if (un < 2048) {
            blk_load4(rk, gK + (size_t)un * 16384, tid); blk_load4(rv, gV + (size_t)un * 16384, tid); blk_load4(rr, gR + (size_t)un * 16384, tid);
#pragma unroll
            for (int ks = 0; ks < 4; ++ks) qn[ks] = *(const bf16x8*)(gQ + (size_t)un * 16384 + ks * 32);
        }
        const int s = c * 128 + n0 + fr;
        const bf16_t* gp = (const bf16_t*)(ws + WS_RG) + ((size_t)bh * SEQ + s) * HD + fq * 4;
        __builtin_amdgcn_sched_barrier(0);
        const float l2g = l2gamma(h);
        f32x4 ot[8];
        float basef = (float)(n0 + fr - 8 * fq);
        asm volatile("" : "+v"(basef));
        const float lb = l2g * basef;
        const float xi = ex2(l2g * (float)(n0 + fr + 1));
#pragma unroll
        for (int et = 0; et < 8; ++et) {
            ot[et] = (f32x4){0.f, 0.f, 0.f, 0.f};
#pragma unroll
            for (int ks = 0; ks < 4; ++ks) { const bf16x8 rf = *(const LAS bf16x8*)(Rs + (et * 16 + fr) * 272 + ks * 64 + fq * 16); ot[et] = MFMA16(rf, qf[ks], ot[et]); }
            ot[et] *= xi;
        }
        __builtin_amdgcn_sched_barrier(0);
        u32x2 gw[8];
#pragma unroll
        for (int et = 0; et < 8; ++et) gw[et] = *(const u32x2*)(gp + et * 16);
        __builtin_amdgcn_sched_barrier(0);
#pragma unroll
        for (int kk = 0; kk < 4; ++kk) {
            if (2 * kk <= w) {
                f32x4 st[2];
#pragma unroll
                for (int tt = 0; tt < 2; ++tt) {
                    st[tt] = (f32x4){0.f, 0.f, 0.f, 0.f};
#pragma unroll
                    for (int ks = 0; ks < 4; ++ks) { const bf16x8 kf = *(const LAS bf16x8*)(Ks + (32 * kk + 4 * tt + 8 * (fr >> 2) + (fr & 3)) * 272 + ks * 64 + fq * 16); st[tt] = MFMA16(kf, qf[ks], st[tt]); }
#pragma unroll
                    for (int j = 0; j < 4; ++j) {
                        const float cj = (float)(32 * kk + 4 * tt + j);
                        st[tt][j] = (basef >= cj) ? st[tt][j] * ex2(lb - l2g * cj) : 0.f;
                    }
                }
                u32x4 pw; pw.x = pk2(st[0][0], st[0][1]); pw.y = pk2(st[0][2], st[0][3]); pw.z = pk2(st[1][0], st[1][1]); pw.w = pk2(st[1][2], st[1][3]);
                const bf16x8 pf = __builtin_bit_cast(bf16x8, pw);
#pragma unroll
                for (int et = 0; et < 8; ++et) { const bf16x8 vf = *(const LAS bf16x8*)(Vs + (et * 16 + fr) * 272 + (32 * kk + 8 * fq) * 2); ot[et] = MFMA16(vf, pf, ot[et]); }
            }
        }
        float sum = 0.f;
#pragma unroll
        for (int et = 0; et < 8; ++et)
#pragma unroll
            for (int j = 0; j < 4; ++j) sum += ot[et][j];
        sum += __shfl_xor(sum, 16); sum += __shfl_xor(sum, 32);
        const float mean = sum * (1.f / HD);
        float sq = 0.f;
#pragma unroll
        for (int et = 0; et < 8; ++et)
#pragma unroll
            for (int j = 0; j < 4; ++j) { const float d = ot[et][j] - mean; sq += d * d; }
        sq += __shfl_xor(sq, 16); sq += __shfl_xor(sq, 32);
        const float rstd = rsqrtf(sq * (1.f / HD) + EPS);
        bf16_t* mp = (bf16_t*)(ws + WS_MIX) + ((size_t)(b * SEQ + s)) * DM + h * HD + fq * 4;
#pragma unroll
        for (int et = 0; et < 8; ++et) {
            const f32x4 gn = *(const LAS f32x4*)(Gs + h * HD + et * 16 + fq * 4), gb = *(const LAS f32x4*)(Gs + 1024 + h * HD + et * 16 + fq * 4);
            const float g0 = __uint_as_float(gw[et].x << 16), g1 = __uint_as_float(gw[et].x & 0xffff0000u), g2 = __uint_as_float(gw[et].y << 16), g3 = __uint_as_float(gw[et].y & 0xffff0000u);
            u32x2 wv;
            wv.x = pk2(((ot[et][0] - mean) * rstd * gn[0] + gb[0]) * g0, ((ot[et][1] - mean) * rstd * gn[1] + gb[1]) * g1);
            wv.y = pk2(((ot[et][2] - mean) * rstd * gn[2] + gb[2]) * g2, ((ot[et][3] - mean) * rstd * gn[3] + gb[3]) * g3);
            *(u32x2*)(mp + et * 16) = wv;
        }
        __syncthreads();
    }
}

DI void phase_final(const Params& p) {
    const int wid = threadIdx.x >> 6, lane = threadIdx.x & 63;
    const float* ssp = (const float*)(p.ws + WS_SSP);
    f32x4 g[8];
#pragma unroll
    for (int i = 0; i < 8; ++i) g[i] = ((const f32x4*)p.fg)[lane + 64 * i];
    for (int row = blockIdx.x * 8 + wid; row < NTOK; row += gridDim.x * 8) {
        float ss = (lane < 32) ? ssp[(size_t)row * 32 + lane] : 0.f;
        f32x4* yr = (f32x4*)(p.out + (size_t)row * DM);
        f32x4 v[8];
#pragma unroll
        for (int i = 0; i < 8; ++i) v[i] = yr[lane + 64 * i];
        ss = wave_sum(ss);
        const float rstd = rsqrtf(ss * (1.f / DM) + EPS);
#pragma unroll
        for (int i = 0; i < 8; ++i) yr[lane + 64 * i] = v[i] * rstd * g[i];
    }
}

#ifndef PHM
#define PHM 127
#endif
__global__ void __launch_bounds__(512, 2) mega(Params p) {
    extern __shared__ __attribute__((aligned(16))) unsigned char shm[];
    LAS unsigned char* lds = (LAS unsigned char*)shm;
    cg::grid_group grid = cg::this_grid();
    volatile LAS unsigned* xst = (volatile LAS unsigned*)(lds + 131072 + 6400);
    if (threadIdx.x == 0) { xst[0] = 0u; xst[1] = 0u; }
    __syncthreads();
    const XcdBarrier xb = xcd_barrier_post((unsigned*)(p.ws + WS_BAR), xst);
    const bool coop = (p.ph_lo == 0 && p.ph_hi == 7);
#define RUNS(k) (p.ph_lo <= (k) && (k) < p.ph_hi)
#define SYNC_AFTER(k) do { if (RUNS(k) && (k) + 1 < p.ph_hi) { if (coop) xcd_barrier(xb); else grid.sync(); } } while (0)
    if (RUNS(0)) { if (PHM & 1) phase_prep(p, lds); }
    SYNC_AFTER(0);
    if (RUNS(1)) { if (PHM & 2) { Epi1 e; e.ws = p.ws; gemm_phase(lds, (const bf16_t*)(p.ws + WS_HB), (const bf16_t*)(p.ws + WS_WTIN), NTOK, INC, DM, e, 0); } }
    SYNC_AFTER(1);
    if (RUNS(2)) { if (PHM & 4) phase_mix1(p, lds); }
    SYNC_AFTER(2);
    if (RUNS(4)) { if (PHM & 16) phase_mix2(p, lds); }
    SYNC_AFTER(4);
    const bool fuse_norm = (gridDim.x == 256);
    if (RUNS(5)) { if (PHM & 32) {
        if (fuse_norm) { Epi2F e; e.x = p.x; e.out = p.out; e.ssp = (float*)(p.ws + WS_SSP); e.cnt = (unsigned*)(p.ws + WS_CNT); e.fg = p.fg; e.xl = (LAS float*)(lds + 131072); gemm_phase(lds, (const bf16_t*)(p.ws + WS_MIX), (const bf16_t*)(p.ws + WS_WTOUT), NTOK, DM, DM, e, 1); }
        else { Epi2 e; e.x = p.x; e.out = p.out; e.ssp = (float*)(p.ws + WS_SSP); gemm_phase(lds, (const bf16_t*)(p.ws + WS_MIX), (const bf16_t*)(p.ws + WS_WTOUT), NTOK, DM, DM, e, 0); } } }
    if (!fuse_norm) {
    SYNC_AFTER(5);
    if (RUNS(6)) { if (PHM & 64) phase_final(p); }
    }
}

constexpr int LDS_BYTES = 131072 + 8192;
#ifndef N_LAUNCH_MODE
#define N_LAUNCH_MODE 1
#endif

extern "C" void kernel_launch(void* const* d_in, const int* in_sizes, int n_in, void* d_out, int out_size, void* d_ws, size_t ws_size, hipStream_t stream) {
    static int grid = 0;
    if (grid == 0) {
        if (ws_size < WS_END) { fprintf(stderr, "kernel_launch: workspace too small (%zu < %zu)\n", ws_size, (size_t)WS_END); grid = -1; return; }
        int dev = 0, cus = 0, per_cu = 0;
        hipGetDevice(&dev);
        hipDeviceGetAttribute(&cus, hipDeviceAttributeMultiprocessorCount, dev);
        if (hipFuncSetAttribute((const void*)mega, hipFuncAttributeMaxDynamicSharedMemorySize, LDS_BYTES) != hipSuccess) { fprintf(stderr, "kernel_launch: hipFuncSetAttribute failed\n"); grid = -1; return; }
        if (hipOccupancyMaxActiveBlocksPerMultiprocessor(&per_cu, (const void*)mega, 512, LDS_BYTES) != hipSuccess || per_cu < 1) per_cu = 1;
        (void)hipGetLastError();
        grid = cus * 1;
        if (grid <= 0) grid = 256;
    }
    if (grid < 0) return;
    Params p{};
    p.x = (const float*)d_in[0]; p.ng = (const float*)d_in[1]; p.w_in = (const float*)d_in[2]; p.gng = (const float*)d_in[3]; p.gnb = (const float*)d_in[4];
    p.sbg = (const float*)d_in[5]; p.w_out = (const float*)d_in[6]; p.fg = (const float*)d_in[7];
    p.out = (float*)d_out; p.ws = (unsigned char*)d_ws;
#if N_LAUNCH_MODE == 1
    (void)hipMemsetAsync((char*)d_ws + WS_BAR, 0, 16384, stream);
    p.ph_lo = 0; p.ph_hi = 7;
    void* args[] = {&p};
    hipError_t e = hipLaunchCooperativeKernel((const void*)mega, dim3(grid), dim3(512), args, LDS_BYTES, stream);
    if (e != hipSuccess) fprintf(stderr, "cooperative launch failed: %s (grid %d)\n", hipGetErrorString(e), grid);
#else
    for (int ph = 0; ph < 7; ++ph) {
        p.ph_lo = ph; p.ph_hi = ph + 1;
        hipLaunchKernelGGL(mega, dim3(grid), dim3(512), LDS_BYTES, stream, p);
    }
#endif
}
```
